# Optimizing an MI355X kernel written in HIP

```python
import math
import jax, jax.numpy as jnp
from jax import lax
import numpy as np

D_MODEL = 4096
BATCH = 4
SEQ = 4096
DEPTH = 1

HEAD_DIM = 128
N_DIFF_HEADS = D_MODEL // (4 * HEAD_DIM)
N_FOX_HEADS = D_MODEL // (2 * HEAD_DIM)
DIFF_WIDTH = N_DIFF_HEADS * 2 * HEAD_DIM
FOX_WIDTH = N_FOX_HEADS * HEAD_DIM
MIX_WIDTH = DIFF_WIDTH + FOX_WIDTH
IN_COLS = 3 * DIFF_WIDTH + 3 * FOX_WIDTH + N_FOX_HEADS
D_FF = ((8 * D_MODEL + 3 * 256 - 1) // (3 * 256)) * 256
NUM_BUCKETS = 32
MAX_DISTANCE = 128
Q_BLOCK = 128
EPS = 1e-6
NEG_INF = -1e30

kernel_name = "hybrid_diffattn_fox_parallel_heads"


def rmsnorm(x, g):
    xf = x.astype(jnp.float32)
    y = xf * lax.rsqrt(jnp.mean(xf * xf, axis=-1, keepdims=True) + EPS)
    return (y * g.astype(jnp.float32)).astype(x.dtype)


def lambda_init(layer_idx):
    return 0.8 - 0.6 * math.exp(-0.3 * layer_idx)


def t5_causal_bucket(n):
    max_exact = NUM_BUCKETS // 2
    nf = jnp.maximum(n, 1).astype(jnp.float32)
    large = max_exact + (jnp.log(nf / max_exact) / math.log(MAX_DISTANCE / max_exact)
                         * (NUM_BUCKETS - max_exact)).astype(jnp.int32)
    large = jnp.minimum(large, NUM_BUCKETS - 1)
    return jnp.where(n < max_exact, n, large)


def hybrid_mixer(h, w_in, b_f, lam, rel_bias_table, diff_subln_g, lam_init, w_o):
    B, S, _ = h.shape
    proj = h @ w_in
    o = 0
    dq = proj[..., o:o + DIFF_WIDTH]; o += DIFF_WIDTH
    dk = proj[..., o:o + DIFF_WIDTH]; o += DIFF_WIDTH
    dv = proj[..., o:o + DIFF_WIDTH]; o += DIFF_WIDTH
    fq = proj[..., o:o + FOX_WIDTH]; o += FOX_WIDTH
    fk = proj[..., o:o + FOX_WIDTH]; o += FOX_WIDTH
    fv = proj[..., o:o + FOX_WIDTH]; o += FOX_WIDTH
    f_logit = proj[..., o:o + N_FOX_HEADS] + b_f

    dq = dq.reshape(B, S, N_DIFF_HEADS, 2, HEAD_DIM).transpose(0, 2, 3, 1, 4)
    dk = dk.reshape(B, S, N_DIFF_HEADS, 2, HEAD_DIM).transpose(0, 2, 3, 1, 4)
    dv = dv.reshape(B, S, N_DIFF_HEADS, 2 * HEAD_DIM).transpose(0, 2, 1, 3)
    fq = fq.reshape(B, S, N_FOX_HEADS, HEAD_DIM).transpose(0, 2, 1, 3)
    fk = fk.reshape(B, S, N_FOX_HEADS, HEAD_DIM).transpose(0, 2, 1, 3)
    fv = fv.reshape(B, S, N_FOX_HEADS, HEAD_DIM).transpose(0, 2, 1, 3)
    log_f = jax.nn.log_sigmoid(f_logit.astype(jnp.float32))
    cum = jnp.cumsum(log_f, axis=1).transpose(0, 2, 1)

    scale = HEAD_DIM ** -0.5
    k_pos = jnp.arange(S, dtype=jnp.int32)
    n_blocks = S // Q_BLOCK

    def block(i):
        start = i * Q_BLOCK
        q_pos = start + jnp.arange(Q_BLOCK, dtype=jnp.int32)
        dist = q_pos[:, None] - k_pos[None, :]
        causal = dist >= 0
        bias = rel_bias_table[t5_causal_bucket(jnp.maximum(dist, 0))]
        bias = bias.astype(jnp.float32).transpose(2, 0, 1)

        q_d = lax.dynamic_slice_in_dim(dq, start, Q_BLOCK, axis=3)
        s_d = jnp.einsum('bhmqd,bhmkd->bhmqk', q_d, dk).astype(jnp.float32) * scale
        s_d = s_d + bias[None, :, None]
        s_d = jnp.where(causal, s_d, NEG_INF)
        p_d = jax.nn.softmax(s_d, axis=-1)
        a_d = p_d[:, :, 0] - lam * p_d[:, :, 1]
        o_d = jnp.einsum('bhqk,bhkd->bhqd', a_d.astype(dv.dtype), dv)

        q_f = lax.dynamic_slice_in_dim(fq, start, Q_BLOCK, axis=2)
        c_q = lax.dynamic_slice_in_dim(cum, start, Q_BLOCK, axis=2)
        s_f = jnp.einsum('bhqd,bhkd->bhqk', q_f, fk).astype(jnp.float32) * scale
        s_f = s_f + (c_q[..., :, None] - cum[..., None, :])
        s_f = jnp.where(causal, s_f, NEG_INF)
        p_f = jax.nn.softmax(s_f, axis=-1)
        o_f = jnp.einsum('bhqk,bhkd->bhqd', p_f.astype(fv.dtype), fv)
        return o_d, o_f

    o_d, o_f = lax.map(block, jnp.arange(n_blocks))
    o_d = o_d.transpose(1, 0, 3, 2, 4).reshape(B, S, N_DIFF_HEADS, 2 * HEAD_DIM)
    o_f = o_f.transpose(1, 0, 3, 2, 4).reshape(B, S, N_FOX_HEADS, HEAD_DIM)
    o_d = rmsnorm(o_d, diff_subln_g) * (1.0 - lam_init)
    mixed = jnp.concatenate([o_d.reshape(B, S, DIFF_WIDTH),
                             o_f.reshape(B, S, FOX_WIDTH)], axis=-1)
    return mixed @ w_o


def swiglu(h, w_gate, w_up, w_down):
    return (jax.nn.silu(h @ w_gate) * (h @ w_up)) @ w_down


def setup_inputs(seed: int = 0) -> dict:
    key = jax.random.key(seed)
    ks = jax.random.split(key, 20)
    f32 = jnp.float32
    nrm = lambda k, shape, s: jax.random.normal(k, shape, f32) * s
    return {
        "x": nrm(ks[0], (BATCH, SEQ, D_MODEL), 1.0),
        "attn_norm_g": 1.0 + nrm(ks[1], (DEPTH, D_MODEL), 0.02),
        "w_in": nrm(ks[2], (DEPTH, D_MODEL, IN_COLS), D_MODEL ** -0.5),
        "b_f": 3.0 + nrm(ks[3], (DEPTH, N_FOX_HEADS), 0.5),
        "lambda_q1": nrm(ks[4], (DEPTH, HEAD_DIM), 0.1),
        "lambda_k1": nrm(ks[5], (DEPTH, HEAD_DIM), 0.1),
        "lambda_q2": nrm(ks[6], (DEPTH, HEAD_DIM), 0.1),
        "lambda_k2": nrm(ks[7], (DEPTH, HEAD_DIM), 0.1),
        "rel_bias_table": nrm(ks[8], (NUM_BUCKETS, N_DIFF_HEADS), 0.5),
        "diff_subln_g": 1.0 + nrm(ks[9], (DEPTH, 2 * HEAD_DIM), 0.02),
        "w_o": nrm(ks[10], (DEPTH, MIX_WIDTH, D_MODEL), MIX_WIDTH ** -0.5),
        "ffn_norm_g": 1.0 + nrm(ks[11], (DEPTH, D_MODEL), 0.02),
        "w_gate": nrm(ks[12], (DEPTH, D_MODEL, D_FF), D_MODEL ** -0.5),
        "w_up": nrm(ks[13], (DEPTH, D_MODEL, D_FF), D_MODEL ** -0.5),
        "w_down": nrm(ks[14], (DEPTH, D_FF, D_MODEL), D_FF ** -0.5),
        "final_norm_g": 1.0 + nrm(ks[15], (D_MODEL,), 0.02),
    }


def reference(x, attn_norm_g, w_in, b_f, lambda_q1, lambda_k1, lambda_q2, lambda_k2,
              rel_bias_table, diff_subln_g, w_o, ffn_norm_g, w_gate, w_up, w_down,
              final_norm_g):
    for l in range(DEPTH):
        lam_init = lambda_init(l)
        lam = (jnp.exp(jnp.sum(lambda_q1[l].astype(jnp.float32) * lambda_k1[l].astype(jnp.float32)))
               - jnp.exp(jnp.sum(lambda_q2[l].astype(jnp.float32) * lambda_k2[l].astype(jnp.float32)))
               + lam_init)
        h = rmsnorm(x, attn_norm_g[l])
        x = x + hybrid_mixer(h, w_in[l], b_f[l], lam, rel_bias_table, diff_subln_g[l],
                             lam_init, w_o[l])
        h = rmsnorm(x, ffn_norm_g[l])
        x = x + swiglu(h, w_gate[l], w_up[l], w_down[l])
    return rmsnorm(x, final_norm_g)
```

```cpp
#include <hip/hip_runtime.h>
#include <cstdio>
#include <cstdint>
#include <cmath>
namespace pg8 {
#define PG8_LAS __attribute__((address_space(3)))
typedef unsigned short bf16_t;
typedef short bf16x8 __attribute__((ext_vector_type(8)));
typedef float f32x4 __attribute__((ext_vector_type(4)));
typedef unsigned u32x4 __attribute__((ext_vector_type(4)));
constexpr int BM = 256, BK = 64, HALF = 128, HTB = HALF * BK * 2  , STAGE_BYTES = 8 * HTB, NXCD = 8, WGM = 8;

__host__ __device__ __forceinline__ int lds_byte(int r, int c) { const int st = (r >> 4) * 2 + (c >> 5), rr = r & 15, cc = c & 31, ob = rr * 64 + cc * 2; return st * 1024 + (ob ^ (((ob >> 9) & 1) << 5)); }
__host__ __device__ __forceinline__ void stage_rc(int b, int& R, int& C) { const int st = b / 1024, sb = b % 1024, swz = sb ^ (((sb >> 9) & 1) << 5); R = (st >> 1) * 16 + swz / 64; C = (st & 1) * 32 + (swz % 64) / 2; }
__host__ __device__ __forceinline__ int perm32(int rho) { const int n = rho >> 4, i = rho & 15; return 8 * (i >> 2) + 4 * n + (i & 3); }

struct Unit { int pm, pn; };
struct Gemm { const bf16_t* A; const bf16_t* Bt; int M, N, K; };

struct StaticOrder {
    int nM, nN, nwg, G, c;
    __host__ __device__ void init(int M, int N, int G_, int c_) { nM = M / BM; nN = N / BM; nwg = nM * nN; G = G_; c = c_; }
    __host__ __device__ bool next(int i, Unit& u) const {
        const long L = (long)i * G + c; if (L >= nwg) return false;
        int wgid = (int)L; { const int q = nwg / NXCD, r = nwg % NXCD, xcd = wgid % NXCD, off = wgid / NXCD; wgid = (xcd < r ? xcd * (q + 1) : r * (q + 1) + (xcd - r) * q) + off; }
        const int nig = WGM * nN, gid = wgid / nig, fm = gid * WGM, gsz = (nM - fm) < WGM ? (nM - fm) : WGM;
        u.pm = fm + ((wgid % nig) % gsz); u.pn = (wgid % nig) / gsz; return true;
    }
    __device__ __forceinline__ void a_ready(const Unit&) const {}
    __device__ __forceinline__ void done(const Unit&) const {}
};

__device__ __forceinline__ unsigned cvt_pk_bf16(float lo, float hi) { unsigned r; asm volatile("v_cvt_pk_bf16_f32 %0, %1, %2" : "=v"(r) : "v"(lo), "v"(hi)); return r; }
typedef float f32x2 __attribute__((ext_vector_type(2)));
__device__ __forceinline__ int fresh_lane() { int l; asm volatile("v_mbcnt_lo_u32_b32 %0, -1, 0\n\tv_mbcnt_hi_u32_b32 %0, -1, %0" : "=v"(l)); return l; }
__device__ __forceinline__ int fresh_tid(int wave) { return wave * 64 + fresh_lane(); }
struct EpiBf16Plain {
    static constexpr bool PERM = true, AFTER_DRAIN = false;
    bf16_t* O; int ldc;
    __device__ __forceinline__ void operator()(const f32x4 (&acc)[2][2][4][2], const Unit& u, int wr, int wc, int fr, int fq) const {
        const int row0 = u.pm * BM + wr * 64 + fr, col0 = u.pn * BM + wc * 32 + 8 * fq;
#pragma unroll
        for (int ai = 0; ai < 2; ++ai)
#pragma unroll
            for (int m = 0; m < 4; ++m) { bf16_t* rowp = O + (size_t)(row0 + ai * HALF + m * 16) * ldc + col0;
#pragma unroll
                for (int bj = 0; bj < 2; ++bj) { const f32x4 v0 = acc[ai][bj][m][0], v1 = acc[ai][bj][m][1];
                    u32x4 w; w.x = cvt_pk_bf16(v0[0], v0[1]); w.y = cvt_pk_bf16(v0[2], v0[3]); w.z = cvt_pk_bf16(v1[0], v1[1]); w.w = cvt_pk_bf16(v1[2], v1[3]);
                    *(u32x4*)(rowp + bj * HALF) = w; } }
    }
};
__device__ __forceinline__ float silu_mul(float g, float u) { return g * __builtin_amdgcn_rcpf(1.0f + __builtin_amdgcn_exp2f(g * -1.4426950408889634f)) * u; }
struct EpiSwiGLU {
    static constexpr bool PERM = true, AFTER_DRAIN = false;
    bf16_t* O; int ldc; const float* rowss; float inv_k, eps;
    __device__ __forceinline__ void operator()(const f32x4 (&acc)[2][2][4][2], const Unit& u, int wr, int wc, int fr, int fq) const {
        const int row0 = u.pm * BM + wr * 64 + fr, col0 = u.pn * HALF + wc * 32 + 8 * fq;
#pragma unroll
        for (int ai = 0; ai < 2; ++ai)
#pragma unroll
            for (int m = 0; m < 4; ++m) { const int row = row0 + ai * HALF + m * 16; bf16_t* rowp = O + (size_t)row * ldc + col0;
                const float rr = __builtin_amdgcn_rsqf(rowss[row] * inv_k + eps);
                const f32x4 g0 = acc[ai][0][m][0] * rr, g1 = acc[ai][0][m][1] * rr, u0 = acc[ai][1][m][0] * rr, u1 = acc[ai][1][m][1] * rr;
                u32x4 w; w.x = cvt_pk_bf16(silu_mul(g0[0], u0[0]), silu_mul(g0[1], u0[1])); w.y = cvt_pk_bf16(silu_mul(g0[2], u0[2]), silu_mul(g0[3], u0[3]));
                w.z = cvt_pk_bf16(silu_mul(g1[0], u1[0]), silu_mul(g1[1], u1[1])); w.w = cvt_pk_bf16(silu_mul(g1[2], u1[2]), silu_mul(g1[3], u1[3]));
                *(u32x4*)rowp = w; }
    }
};
template <bool STATS> struct EpiResF32 {
    static constexpr bool PERM = true, AFTER_DRAIN = false;
    const float* res; float* out; int ldc; bf16_t* xb; float* rowss;
    __device__ __forceinline__ void operator()(const f32x4 (&acc)[2][2][4][2], const Unit& u, int wr, int wc, int fr, int fq) const {
        const int row0 = u.pm * BM + wr * 64 + fr, col0 = u.pn * BM + wc * 32 + 8 * fq;
#pragma unroll
        for (int ai = 0; ai < 2; ++ai)
#pragma unroll
            for (int m = 0; m < 4; ++m) { const int row = row0 + ai * HALF + m * 16; const size_t off = (size_t)row * ldc + col0;
                f32x4 r[2][2];
#pragma unroll
                for (int bj = 0; bj < 2; ++bj)
#pragma unroll
                    for (int n = 0; n < 2; ++n) r[bj][n] = *(const f32x4*)(res + off + bj * HALF + n * 4);
                float ss = 0.f;
#pragma unroll
                for (int bj = 0; bj < 2; ++bj) {
#pragma unroll
                    for (int n = 0; n < 2; ++n) { r[bj][n] = r[bj][n] + acc[ai][bj][m][n]; *(f32x4*)(out + off + bj * HALF + n * 4) = r[bj][n];
                        if (STATS) ss += (r[bj][n][0] * r[bj][n][0] + r[bj][n][1] * r[bj][n][1]) + (r[bj][n][2] * r[bj][n][2] + r[bj][n][3] * r[bj][n][3]); }
                    if (STATS) { u32x4 w; w.x = cvt_pk_bf16(r[bj][0][0], r[bj][0][1]); w.y = cvt_pk_bf16(r[bj][0][2], r[bj][0][3]); w.z = cvt_pk_bf16(r[bj][1][0], r[bj][1][1]); w.w = cvt_pk_bf16(r[bj][1][2], r[bj][1][3]);
                        *(u32x4*)(xb + off + bj * HALF) = w; } }
                if (STATS) { ss += __shfl_xor(ss, 16); ss += __shfl_xor(ss, 32);
                    if (fq == 0) (void)__hip_atomic_fetch_add(rowss + row, ss, __ATOMIC_RELAXED, __HIP_MEMORY_SCOPE_AGENT); } }
    }
};

struct EpiResF32Plain {
    static constexpr bool PERM = false, AFTER_DRAIN = false;
    const float* res; float* out; int ldc;
    __device__ __forceinline__ void operator()(const f32x4 (&acc)[2][2][4][2], const Unit& u, int wr, int wc, int fr, int fq) const {
        const int row0 = u.pm * BM + wr * 64 + fr, col0 = u.pn * BM + wc * 32 + 4 * fq;
#pragma unroll
        for (int ai = 0; ai < 2; ++ai)
#pragma unroll
            for (int m = 0; m < 4; ++m) { const size_t off = (size_t)(row0 + ai * HALF + m * 16) * ldc + col0;
                f32x4 r[2][2];
#pragma unroll
                for (int bj = 0; bj < 2; ++bj)
#pragma unroll
                    for (int n = 0; n < 2; ++n) r[bj][n] = *(const f32x4*)(res + off + bj * HALF + n * 16);
#pragma unroll
                for (int bj = 0; bj < 2; ++bj)
#pragma unroll
                    for (int n = 0; n < 2; ++n) *(f32x4*)(out + off + bj * HALF + n * 16) = r[bj][n] + acc[ai][bj][m][n]; }
    }
};

struct EpiResToBf16Stats {
    static constexpr bool PERM = true, AFTER_DRAIN = false;
    const float* res; bf16_t* xb; int ldc; float* rowss;
    __device__ __forceinline__ void operator()(const f32x4 (&acc)[2][2][4][2], const Unit& u, int wr, int wc, int fr, int fq) const {
        const int row0 = u.pm * BM + wr * 64 + fr, col0 = u.pn * BM + wc * 32 + 8 * fq;
        f32x4 rA[2][2][2], rB[2][2][2];
#define EPI_LOAD(dst, q) do { _Pragma("unroll") for (int h_ = 0; h_ < 2; ++h_) { const int gi_ = 2 * (q) + h_; const size_t off_ = (size_t)(row0 + (gi_ >> 2) * HALF + (gi_ & 3) * 16) * ldc + col0;          \
            _Pragma("unroll") for (int bj = 0; bj < 2; ++bj) _Pragma("unroll") for (int n = 0; n < 2; ++n) dst[h_][bj][n] = *(const f32x4*)(res + off_ + bj * HALF + n * 4); } } while (0)
#define EPI_DONE(src, q) do { _Pragma("unroll") for (int h_ = 0; h_ < 2; ++h_) { const int gi_ = 2 * (q) + h_, ai = gi_ >> 2, m = gi_ & 3; const int row = row0 + ai * HALF + m * 16; const size_t off = (size_t)row * ldc + col0;   \
            float ss = 0.f;                                                                                                                                                              \
            _Pragma("unroll") for (int bj = 0; bj < 2; ++bj) { f32x4 v0 = src[h_][bj][0] + acc[ai][bj][m][0], v1 = src[h_][bj][1] + acc[ai][bj][m][1];                                     \
                ss += (v0[0] * v0[0] + v0[1] * v0[1]) + (v0[2] * v0[2] + v0[3] * v0[3]) + (v1[0] * v1[0] + v1[1] * v1[1]) + (v1[2] * v1[2] + v1[3] * v1[3]);                               \
                u32x4 w; w.x = cvt_pk_bf16(v0[0], v0[1]); w.y = cvt_pk_bf16(v0[2], v0[3]); w.z = cvt_pk_bf16(v1[0], v1[1]); w.w = cvt_pk_bf16(v1[2], v1[3]);                               \
                *(u32x4*)(xb + off + bj * HALF) = w; }                                                                                                                                     \
            ss += __shfl_xor(ss, 16); ss += __shfl_xor(ss, 32);                                                                                                                            \
            if (fq == 0) (void)__hip_atomic_fetch_add(rowss + row, ss, __ATOMIC_RELAXED, __HIP_MEMORY_SCOPE_AGENT); } } while (0)
        EPI_LOAD(rA, 0); EPI_LOAD(rB, 1);
        EPI_DONE(rA, 0); EPI_LOAD(rA, 2);
        EPI_DONE(rB, 1); EPI_LOAD(rB, 3);
        EPI_DONE(rA, 2);
        EPI_DONE(rB, 3);
#undef EPI_LOAD
#undef EPI_DONE
    }
};
struct EpiResBToBf16Stats {
    static constexpr bool PERM = true, AFTER_DRAIN = false;
    const bf16_t* resb; bf16_t* xb; int ldc; float* rowss;
    __device__ __forceinline__ void operator()(const f32x4 (&acc)[2][2][4][2], const Unit& u, int wr, int wc, int fr, int fq) const {
        const int row0 = u.pm * BM + wr * 64 + fr, col0 = u.pn * BM + wc * 32 + 8 * fq;
        u32x4 rA[2][2], rB[2][2];
#define EPI_LOAD(dst, q) do { _Pragma("unroll") for (int h_ = 0; h_ < 2; ++h_) { const int gi_ = 2 * (q) + h_; const size_t off_ = (size_t)(row0 + (gi_ >> 2) * HALF + (gi_ & 3) * 16) * ldc + col0;          \
            _Pragma("unroll") for (int bj = 0; bj < 2; ++bj) dst[h_][bj] = *(const u32x4*)(resb + off_ + bj * HALF); } } while (0)
#define EPI_DONE(src, q) do { _Pragma("unroll") for (int h_ = 0; h_ < 2; ++h_) { const int gi_ = 2 * (q) + h_, ai = gi_ >> 2, m = gi_ & 3; const int row = row0 + ai * HALF + m * 16; const size_t off = (size_t)row * ldc + col0;   \
            float ss = 0.f;                                                                                                                                                              \
            _Pragma("unroll") for (int bj = 0; bj < 2; ++bj) { const u32x4 hb = src[h_][bj];                                                                                              \
                const f32x4 x0 = {__uint_as_float(hb.x << 16), __uint_as_float(hb.x & 0xffff0000u), __uint_as_float(hb.y << 16), __uint_as_float(hb.y & 0xffff0000u)};                    \
                const f32x4 x1 = {__uint_as_float(hb.z << 16), __uint_as_float(hb.z & 0xffff0000u), __uint_as_float(hb.w << 16), __uint_as_float(hb.w & 0xffff0000u)};                    \
                const f32x4 v0 = x0 + acc[ai][bj][m][0], v1 = x1 + acc[ai][bj][m][1];                                                                                                     \
                ss += (v0[0] * v0[0] + v0[1] * v0[1]) + (v0[2] * v0[2] + v0[3] * v0[3]) + (v1[0] * v1[0] + v1[1] * v1[1]) + (v1[2] * v1[2] + v1[3] * v1[3]);                               \
                u32x4 w; w.x = cvt_pk_bf16(v0[0], v0[1]); w.y = cvt_pk_bf16(v0[2], v0[3]); w.z = cvt_pk_bf16(v1[0], v1[1]); w.w = cvt_pk_bf16(v1[2], v1[3]);                               \
                *(u32x4*)(xb + off + bj * HALF) = w; }                                                                                                                                     \
            ss += __shfl_xor(ss, 16); ss += __shfl_xor(ss, 32);                                                                                                                            \
            if (fq == 0) (void)__hip_atomic_fetch_add(rowss + row, ss, __ATOMIC_RELAXED, __HIP_MEMORY_SCOPE_AGENT); } } while (0)
        EPI_LOAD(rA, 0); EPI_LOAD(rB, 1);
        EPI_DONE(rA, 0); EPI_LOAD(rA, 2);
        EPI_DONE(rB, 1); EPI_LOAD(rB, 3);
        EPI_DONE(rA, 2);
        EPI_DONE(rB, 3);
#undef EPI_LOAD
#undef EPI_DONE
    }
};
struct EpiResBf16 {
    static constexpr bool PERM = true, AFTER_DRAIN = false;
    const bf16_t* res; bf16_t* out; int ldc;
    __device__ __forceinline__ void operator()(const f32x4 (&acc)[2][2][4][2], const Unit& u, int wr, int wc, int fr, int fq) const {
        const int row0 = u.pm * BM + wr * 64 + fr, col0 = u.pn * BM + wc * 32 + 8 * fq;
        u32x4 rb[2][4][2];
#pragma unroll
        for (int ai = 0; ai < 2; ++ai)
#pragma unroll
            for (int m = 0; m < 4; ++m)
#pragma unroll
                for (int bj = 0; bj < 2; ++bj) rb[ai][m][bj] = *(const u32x4*)(res + (size_t)(row0 + ai * HALF + m * 16) * ldc + col0 + bj * HALF);
#pragma unroll
        for (int ai = 0; ai < 2; ++ai)
#pragma unroll
            for (int m = 0; m < 4; ++m) { const size_t off = (size_t)(row0 + ai * HALF + m * 16) * ldc + col0;
#pragma unroll
                for (int bj = 0; bj < 2; ++bj) { const f32x4 a0 = acc[ai][bj][m][0], a1 = acc[ai][bj][m][1]; const u32x4 r = rb[ai][m][bj]; u32x4 w;
                    w.x = cvt_pk_bf16(__uint_as_float(r.x << 16) + a0[0], __uint_as_float(r.x & 0xffff0000u) + a0[1]);
                    w.y = cvt_pk_bf16(__uint_as_float(r.y << 16) + a0[2], __uint_as_float(r.y & 0xffff0000u) + a0[3]);
                    w.z = cvt_pk_bf16(__uint_as_float(r.z << 16) + a1[0], __uint_as_float(r.z & 0xffff0000u) + a1[1]);
                    w.w = cvt_pk_bf16(__uint_as_float(r.w << 16) + a1[2], __uint_as_float(r.w & 0xffff0000u) + a1[3]);
                    *(u32x4*)(out + off + bj * HALF) = w; } }
    }
};
struct EpiQKVSlab {
    static constexpr bool PERM = true, AFTER_DRAIN = false;
    bf16_t* O; int seq; const float* rinv;
    __device__ __forceinline__ void operator()(const f32x4 (&acc)[2][2][4][2], const Unit& u, int wr, int wc, int fr, int fq) const {
        const int row0 = u.pm * BM + wr * 64 + fr, b = row0 / seq, s0 = row0 - b * seq;
        float rs[2][4];
#pragma unroll
        for (int ai = 0; ai < 2; ++ai)
#pragma unroll
            for (int m = 0; m < 4; ++m) rs[ai][m] = rinv[row0 + ai * HALF + m * 16];
#pragma unroll
        for (int bj = 0; bj < 2; ++bj) { bf16_t* slab = O + ((size_t)(b * 96 + u.pn * 2 + bj) * seq + s0) * 128 + wc * 32 + 8 * fq;
#pragma unroll
            for (int ai = 0; ai < 2; ++ai)
#pragma unroll
                for (int m = 0; m < 4; ++m) { const f32x4 v0 = acc[ai][bj][m][0] * rs[ai][m], v1 = acc[ai][bj][m][1] * rs[ai][m];
                    u32x4 w; w.x = cvt_pk_bf16(v0[0], v0[1]); w.y = cvt_pk_bf16(v0[2], v0[3]); w.z = cvt_pk_bf16(v1[0], v1[1]); w.w = cvt_pk_bf16(v1[2], v1[3]);
                    *(u32x4*)(slab + (size_t)(ai * HALF + m * 16) * 128) = w; } }
    }
};
template <class Epi, class Sched, bool ALIGN_EPI = false, bool SP2 = false>
__device__ __forceinline__ void gemm_phase(PG8_LAS unsigned char* lds, const Gemm g, const Sched& S, const Epi& E, const int wave) {
    const int tid = fresh_tid(wave), wid = __builtin_amdgcn_readfirstlane(tid >> 6), lane = tid & 63, wr = wid >> 2, wc = wid & 3, fr = lane & 15, fq = lane >> 4;
    const int K = g.K, nt = K / BK;
    unsigned voffA[2], voffB[2];
#pragma unroll
    for (int i = 0; i < 2; ++i) { int R, C; stage_rc(tid * 16 + i * 8192, R, C); const int Rb = Epi::PERM ? ((R & ~31) + perm32(R & 31)) : R;
        voffA[i] = (unsigned)(R * K + C) * 2u; voffB[i] = (unsigned)(Rb * K + C) * 2u; }
    const size_t kstep = (size_t)(BK * 2);
    const size_t hstep = (size_t)HALF * K * 2;
    const size_t tstep = 2 * hstep;
    const unsigned ldsw = (unsigned)wid * 1024u;
    const int aoff = lds_byte(wr * 64 + fr, fq * 8), boff = lds_byte(wc * 32 + fr, fq * 8);
#define PG8_SA(b, h) (((b) * 2 + (h)) * HTB)
#define PG8_SB(b, h) ((4 + (b) * 2 + (h)) * HTB)
#define PG8_STAGE(bufoff, gbase, voff) do { _Pragma("unroll") for (int _i = 0; _i < 2; ++_i) \
        __builtin_amdgcn_global_load_lds((const unsigned*)((const char*)(gbase) + (voff)[_i]), (PG8_LAS unsigned*)(lds + (bufoff) + ldsw + _i * 8192), 16, 0, 0); } while (0)
#define PG8_LDA(dst, b, h) do { _Pragma("unroll") for (int m = 0; m < 4; ++m) _Pragma("unroll") for (int k = 0; k < 2; ++k) dst[m][k] = *(const PG8_LAS bf16x8*)(lds + PG8_SA(b, h) + aoff + m * 2048 + k * 1024); } while (0)
#define PG8_LDB(dst, b, h) do { _Pragma("unroll") for (int n = 0; n < 2; ++n) _Pragma("unroll") for (int k = 0; k < 2; ++k) dst[n][k] = *(const PG8_LAS bf16x8*)(lds + PG8_SB(b, h) + boff + n * 2048 + k * 1024); } while (0)
#define PG8_MMA(ai, bj, At, Bt) do { __builtin_amdgcn_s_setprio(1); _Pragma("unroll") for (int m = 0; m < 4; ++m) _Pragma("unroll") for (int n = 0; n < 2; ++n) _Pragma("unroll") for (int k = 0; k < 2; ++k) \
        acc[ai][bj][m][n] = __builtin_amdgcn_mfma_f32_16x16x32_bf16(Bt[n][k], At[m][k], acc[ai][bj][m][n], 0, 0, 0); __builtin_amdgcn_s_setprio(0); } while (0)
#define PG8_WAIT_V(n) asm volatile("s_waitcnt vmcnt(" #n ")" ::: "memory")
#define PG8_WAIT_L(n) asm volatile("s_waitcnt lgkmcnt(" #n ")" ::: "memory")
#define PG8_BAR __builtin_amdgcn_s_barrier()
#define PG8_SCHED __builtin_amdgcn_sched_barrier(0)
    Unit cur, nxt; int ui = 0;
    if (!S.next(0, cur)) return;
    f32x4 acc[2][2][4][2];
#pragma unroll
    for (int a = 0; a < 2; ++a)
#pragma unroll
        for (int b = 0; b < 2; ++b)
#pragma unroll
            for (int m = 0; m < 4; ++m)
#pragma unroll
                for (int n = 0; n < 2; ++n) acc[a][b][m][n] = (f32x4){0.f, 0.f, 0.f, 0.f};
    bf16x8 At[4][2], B0[2][2], B1[2][2];
    const char* cA = (const char*)g.A + (size_t)cur.pm * tstep; const char* cB = (const char*)g.Bt + (size_t)cur.pn * tstep;
    S.a_ready(cur);
    if constexpr (SP2) {
        PG8_STAGE(PG8_SB(0, 0), cB, voffB); PG8_STAGE(PG8_SB(0, 1), cB + hstep, voffB); PG8_STAGE(PG8_SA(0, 0), cA, voffA); PG8_STAGE(PG8_SA(0, 1), cA + hstep, voffA);
        if (wr == 1) PG8_BAR;
        PG8_WAIT_V(2); PG8_BAR;
        PG8_STAGE(PG8_SB(1, 0), cB + kstep, voffB); PG8_STAGE(PG8_SA(1, 0), cA + kstep, voffA); PG8_STAGE(PG8_SB(1, 1), cB + hstep + kstep, voffB);
        PG8_WAIT_V(6); PG8_BAR;
    } else {
        PG8_STAGE(PG8_SB(0, 0), cB, voffB); PG8_STAGE(PG8_SA(0, 0), cA, voffA); PG8_STAGE(PG8_SB(0, 1), cB + hstep, voffB); PG8_STAGE(PG8_SA(0, 1), cA + hstep, voffA);
        if (wr == 1) PG8_BAR;
        PG8_WAIT_V(4); PG8_BAR;
        PG8_STAGE(PG8_SB(1, 0), cB + kstep, voffB); PG8_STAGE(PG8_SA(1, 0), cA + kstep, voffA); PG8_STAGE(PG8_SB(1, 1), cB + hstep + kstep, voffB);
        PG8_WAIT_V(6); PG8_BAR;
    }
    for (;;) {
        const bool has_next = S.next(ui + 1, nxt);
        const char* nA = has_next ? (const char*)g.A + (size_t)nxt.pm * tstep : cA; const char* nB = has_next ? (const char*)g.Bt + (size_t)nxt.pn * tstep : cB;
        for (int t = 0; t < nt; t += 2) {
            const bool last = (t == nt - 2);
            const char* a1 = cA + (size_t)(t + 1) * kstep;
            const char* a2 = last ? nA : cA + (size_t)(t + 2) * kstep; const char* b2 = last ? nB : cB + (size_t)(t + 2) * kstep;
            const char* a3 = a2 + kstep; const char* b3 = b2 + kstep;
            if (last && has_next) S.a_ready(nxt);
            if constexpr (SP2) {
            PG8_LDB(B0, 0, 0); PG8_LDB(B1, 0, 1); PG8_SCHED; PG8_LDA(At, 0, 0); PG8_STAGE(PG8_SA(1, 1), a1 + hstep, voffA);
            PG8_WAIT_V(8); PG8_WAIT_L(0); PG8_BAR; PG8_MMA(0, 0, At, B0); PG8_MMA(0, 1, At, B1); PG8_BAR; PG8_SCHED;
            PG8_LDA(At, 0, 1); PG8_STAGE(PG8_SB(0, 0), b2, voffB); PG8_STAGE(PG8_SB(0, 1), b2 + hstep, voffB); PG8_STAGE(PG8_SA(0, 0), a2, voffA);
            PG8_WAIT_V(8); PG8_WAIT_L(0); PG8_BAR; PG8_MMA(1, 0, At, B0); PG8_MMA(1, 1, At, B1); PG8_BAR; PG8_SCHED;
            PG8_LDB(B0, 1, 0); PG8_LDB(B1, 1, 1); PG8_SCHED; PG8_LDA(At, 1, 0); PG8_STAGE(PG8_SA(0, 1), a2 + hstep, voffA);
            PG8_WAIT_V(8); PG8_WAIT_L(0); PG8_BAR; PG8_MMA(0, 0, At, B0); PG8_MMA(0, 1, At, B1); PG8_BAR; PG8_SCHED;
            PG8_LDA(At, 1, 1); PG8_STAGE(PG8_SB(1, 0), b3, voffB); PG8_STAGE(PG8_SB(1, 1), b3 + hstep, voffB); PG8_STAGE(PG8_SA(1, 0), a3, voffA);
            PG8_WAIT_V(8); PG8_WAIT_L(0); PG8_BAR; PG8_MMA(1, 0, At, B0); PG8_MMA(1, 1, At, B1); PG8_BAR; PG8_SCHED;
            } else {
            PG8_LDB(B0, 0, 0); PG8_SCHED; PG8_LDA(At, 0, 0); PG8_STAGE(PG8_SA(1, 1), a1 + hstep, voffA);
            PG8_WAIT_L(8); PG8_BAR; PG8_WAIT_L(0); PG8_MMA(0, 0, At, B0); PG8_BAR; PG8_SCHED;
            PG8_LDB(B1, 0, 1); PG8_STAGE(PG8_SB(0, 0), b2, voffB);
            PG8_BAR; PG8_WAIT_L(0); PG8_MMA(0, 1, At, B1); PG8_BAR;
            PG8_LDA(At, 0, 1); PG8_STAGE(PG8_SA(0, 0), a2, voffA);
            PG8_BAR; PG8_WAIT_L(0); PG8_MMA(1, 0, At, B0); PG8_BAR; PG8_SCHED;
            PG8_STAGE(PG8_SB(0, 1), b2 + hstep, voffB);
            PG8_WAIT_V(6); PG8_BAR; PG8_MMA(1, 1, At, B1); PG8_BAR;
            PG8_LDB(B0, 1, 0); PG8_SCHED; PG8_LDA(At, 1, 0); PG8_STAGE(PG8_SA(0, 1), a2 + hstep, voffA);
            PG8_WAIT_L(8); PG8_BAR; PG8_WAIT_L(0); PG8_MMA(0, 0, At, B0); PG8_BAR; PG8_SCHED;
            PG8_LDB(B1, 1, 1); PG8_STAGE(PG8_SB(1, 0), b3, voffB);
            PG8_BAR; PG8_WAIT_L(0); PG8_MMA(0, 1, At, B1); PG8_BAR;
            PG8_LDA(At, 1, 1); PG8_STAGE(PG8_SA(1, 0), a3, voffA);
            PG8_BAR; PG8_WAIT_L(0); PG8_MMA(1, 0, At, B0); PG8_BAR; PG8_SCHED;
            PG8_STAGE(PG8_SB(1, 1), b3 + hstep, voffB);
            PG8_WAIT_V(6); PG8_BAR; PG8_MMA(1, 1, At, B1); PG8_BAR;
            }
        }
        if constexpr (ALIGN_EPI) { if (wr == 0) PG8_BAR; }
        if constexpr (!Epi::AFTER_DRAIN) { E(acc, cur, wr, wc, fr, fq); S.done(cur); }
        if (!has_next) break;
#pragma unroll
        for (int a = 0; a < 2; ++a)
#pragma unroll
            for (int b = 0; b < 2; ++b)
#pragma unroll
                for (int m = 0; m < 4; ++m)
#pragma unroll
                    for (int n = 0; n < 2; ++n) acc[a][b][m][n] = (f32x4){0.f, 0.f, 0.f, 0.f};
        cur = nxt; cA = nA; cB = nB; ++ui;
        if constexpr (ALIGN_EPI) { if (wr == 1) PG8_BAR; }
    }
    PG8_WAIT_V(0);
    if constexpr (!ALIGN_EPI) { if (wr == 0) PG8_BAR; }
    PG8_BAR;
    if constexpr (Epi::AFTER_DRAIN) { E.fused(acc, cur, wr, wc, fr, fq, lds, wid, lane); S.done(cur); }
#undef PG8_SA
#undef PG8_SB
#undef PG8_STAGE
#undef PG8_LDA
#undef PG8_LDB
#undef PG8_MMA
#undef PG8_WAIT_V
#undef PG8_WAIT_L
#undef PG8_BAR
#undef PG8_SCHED
}
}
#ifndef BIASMODE
#define BIASMODE 3
#endif
namespace att {
typedef unsigned short bf16;
typedef short bf16x8 __attribute__((ext_vector_type(8)));
typedef short s16x4 __attribute__((ext_vector_type(4)));
typedef float f32x16 __attribute__((ext_vector_type(16)));
typedef float f32x4 __attribute__((ext_vector_type(4)));
typedef unsigned u32x4 __attribute__((ext_vector_type(4)));
#define ATT_LAS __attribute__((address_space(3)))
constexpr int D = 128, QPITCH = 128, NSLAB = 96, OPITCH = 4096, SKV = 4096, W = 4096;
constexpr float SCALE = 0.08838834764831845f;
constexpr float INV_SCALE = 11.313708498984761f;
constexpr float THR = 8.f;
constexpr int NW = 8, QBLK = 32, KVBLK = 64, QB = NW * QBLK;
constexpr int SHM_V = KVBLK * D * 2, SHM_K = KVBLK * D * 2;
constexpr int LDS_BODY = 2 * SHM_V + 2 * SHM_K + NW * 64 * 4;
constexpr int LDS_KB = 69632;
constexpr int LDS_REL = LDS_KB + 16384;
constexpr int LDS_PRE = LDS_REL + 2048;
constexpr int LDS_OST = LDS_PRE + 256, OST_ROW = 272, OST_WAVE = 16 * OST_ROW;
constexpr int LDS_BYTES_FOX = LDS_OST + NW * OST_WAVE;
constexpr int REL_N = 272, REL_TOP = 207;

#define KSWZ(row, colB) ((row) * 256 + ((colB) ^ (((row) & 7) << 4)))
#define SBAR() __builtin_amdgcn_sched_barrier(0)
__device__ __forceinline__ int v_st(int k, int c) { const int kk = (k & ~0xC) | ((k & 4) << 1) | ((k & 8) >> 1); return ((kk >> 3) * 4 + (c >> 5)) * 512 + ((kk & 7) * 32 + (c & 31)) * 2; }
__device__ __forceinline__ int v_rd_base(int lane) { return ((lane & 3) << 3) | (((lane >> 2) & 3) << 6) | (((lane >> 4) & 1) << 5) | (((lane >> 5) & 1) << 8); }
constexpr int v_rd_off(int d0, int ks, int half) { return d0 * 512 + ks * 4096 + half * 2048; }
__device__ __forceinline__ int crow(int r, int hi) { return (r & 3) + 8 * (r >> 2) + 4 * hi; }
__device__ __forceinline__ unsigned cvtpk(float lo, float hi) {
    unsigned r; asm volatile("v_cvt_pk_bf16_f32 %0, %1, %2" : "=v"(r) : "v"(lo), "v"(hi)); return r;
}
__device__ __forceinline__ bf16x8 load8(const bf16* p) { return *reinterpret_cast<const bf16x8*>(p); }
__device__ __forceinline__ bf16x8 bld8(__amdgpu_buffer_rsrc_t r, unsigned voff, unsigned soff) { return __builtin_bit_cast(bf16x8, __builtin_amdgcn_raw_buffer_load_b128(r, (int)voff, (int)soff, 0)); }
__device__ __forceinline__ void mask_tile(f32x16& p0, f32x16& p1, int dq) {
    const float NEG = -__builtin_inff();
#pragma unroll
    for (int r = 0; r < 16; ++r) {
        const int c = (r & 3) + 8 * (r >> 2);
        if (dq - c < 0) p0[r] = NEG;
        if (dq - c - 32 < 0) p1[r] = NEG;
    }
}
__device__ __forceinline__ void bias_key(f32x16& p0, f32x16& p1, const ATT_LAS float* kb) {
#pragma unroll
    for (int g = 0; g < 4; ++g) {
        const f32x4 a = *(const ATT_LAS f32x4*)(kb + 8 * g), b = *(const ATT_LAS f32x4*)(kb + 32 + 8 * g);
#pragma unroll
        for (int j = 0; j < 4; ++j) { p0[4 * g + j] += a[j]; p1[4 * g + j] += b[j]; }
    }
}
__device__ __forceinline__ void bias_rel(f32x16& p0, f32x16& p1, const ATT_LAS float* rp) {
#pragma unroll
    for (int r = 0; r < 16; ++r) {
        const int c = (r & 3) + 8 * (r >> 2);
        p0[r] += rp[c]; p1[r] += rp[c + 32];
    }
}
__device__ __forceinline__ void partialSM(f32x16& p0, f32x16& p1, float& m_reg, float& mn, float& alpha) {
    float pmax = p0[0]; for (int r = 1; r < 16; ++r) pmax = fmaxf(pmax, p0[r]); for (int r = 0; r < 16; ++r) pmax = fmaxf(pmax, p1[r]);
    { auto rr = __builtin_amdgcn_permlane32_swap(__float_as_uint(pmax), __float_as_uint(pmax), false, false);
      pmax = fmaxf(__uint_as_float(rr[0]), __uint_as_float(rr[1])); }
    constexpr float C2 = 1.4426950408889634f * SCALE;
    if (__builtin_expect(__all((pmax - m_reg) * SCALE <= THR), 1)) { mn = m_reg; alpha = 1.f; }
    else { mn = fmaxf(m_reg, pmax); alpha = __builtin_amdgcn_exp2f((m_reg - mn) * C2); m_reg = mn; }
    const float mnL = -mn * C2;
    for (int r = 0; r < 16; ++r) p0[r] = fmaf(p0[r], C2, mnL); for (int r = 0; r < 16; ++r) p1[r] = fmaf(p1[r], C2, mnL);
    for (int r = 0; r < 16; ++r) p0[r] = __builtin_amdgcn_exp2f(p0[r]);
}
__device__ __forceinline__ void finishSM(f32x16& p0, f32x16& p1, float alpha, float& l_reg, bf16x8& pa0, bf16x8& pa1, bf16x8& pa2, bf16x8& pa3) {
    for (int r = 0; r < 16; ++r) p1[r] = __builtin_amdgcn_exp2f(p1[r]);
    float ps = 0; for (int r = 0; r < 16; ++r) ps += p0[r]; for (int r = 0; r < 16; ++r) ps += p1[r];
    { auto rr = __builtin_amdgcn_permlane32_swap(__float_as_uint(ps), __float_as_uint(ps), false, false);
      ps = __uint_as_float(rr[0]) + __uint_as_float(rr[1]); }
    l_reg = l_reg * alpha + ps;
#define PK4(P, B_, OUT) do { unsigned a0 = cvtpk(P[B_+0], P[B_+1]), a1 = cvtpk(P[B_+2], P[B_+3]);                          \
        unsigned b0 = cvtpk(P[B_+4], P[B_+5]), b1 = cvtpk(P[B_+6], P[B_+7]);                                             \
        auto r0 = __builtin_amdgcn_permlane32_swap(a0, b0, false, false); auto r1 = __builtin_amdgcn_permlane32_swap(a1, b1, false, false); \
        u32x4 w = {r0[0], r1[0], r0[1], r1[1]}; OUT = *reinterpret_cast<bf16x8*>(&w); } while (0)
    PK4(p0, 0, pa0); PK4(p0, 8, pa1); PK4(p1, 0, pa2); PK4(p1, 8, pa3);
#undef PK4
}
template <int KB>
__device__ __forceinline__ void qkt(f32x16& p0, f32x16& p1, const char* K_lds, int r32, int hi, const bf16x8* qr) {
    p0 = f32x16{}; p1 = f32x16{};
    const char* kb[4];
#pragma unroll
    for (int dd = 0; dd < 4; ++dd) kb[dd] = K_lds + KB * SHM_K + KSWZ(r32, (dd * 16 + hi * 8) * 2);
#pragma unroll
    for (int d0 = 0; d0 < 8; ++d0) { const char* a = kb[d0 & 3] + (d0 >> 2) * 128;
        bf16x8 b0 = *reinterpret_cast<const bf16x8*>(a);
        bf16x8 b1 = *reinterpret_cast<const bf16x8*>(a + 32 * 256);
        p0 = __builtin_amdgcn_mfma_f32_32x32x16_bf16(b0, qr[d0], p0, 0, 0, 0);
        p1 = __builtin_amdgcn_mfma_f32_32x32x16_bf16(b1, qr[d0], p1, 0, 0, 0); }
}
template <int VB>
__device__ __forceinline__ void pv_tile(f32x16* o, int vb0, bf16x8 pa0, bf16x8 pa1, bf16x8 pa2, bf16x8 pa3) {
#define TRRD(dst, off) asm volatile("ds_read_b64_tr_b16 %0, %1 offset:%2" : "=&v"(dst) : "v"(vb0), "i"(off) : "memory")
#define PV_D0(d0) do { s16x4 l0, l1, l2, l3, h0, h1, h2, h3; constexpr int b_ = VB * SHM_V + v_rd_off(d0, 0, 0);     \
        TRRD(l0, b_); TRRD(h0, b_ + 2048); TRRD(l1, b_ + 4096); TRRD(h1, b_ + 6144); TRRD(l2, b_ + 8192); TRRD(h2, b_ + 10240); TRRD(l3, b_ + 12288); TRRD(h3, b_ + 14336); \
        asm volatile("s_waitcnt lgkmcnt(0)" ::: "memory"); SBAR();                                                           \
        o[d0] = __builtin_amdgcn_mfma_f32_32x32x16_bf16(pa0, (bf16x8){l0[0], l0[1], l0[2], l0[3], h0[0], h0[1], h0[2], h0[3]}, o[d0], 0, 0, 0);   \
        o[d0] = __builtin_amdgcn_mfma_f32_32x32x16_bf16(pa1, (bf16x8){l1[0], l1[1], l1[2], l1[3], h1[0], h1[1], h1[2], h1[3]}, o[d0], 0, 0, 0);   \
        o[d0] = __builtin_amdgcn_mfma_f32_32x32x16_bf16(pa2, (bf16x8){l2[0], l2[1], l2[2], l2[3], h2[0], h2[1], h2[2], h2[3]}, o[d0], 0, 0, 0);   \
        o[d0] = __builtin_amdgcn_mfma_f32_32x32x16_bf16(pa3, (bf16x8){l3[0], l3[1], l3[2], l3[3], h3[0], h3[1], h3[2], h3[3]}, o[d0], 0, 0, 0); } while (0)
    PV_D0(0); PV_D0(1); PV_D0(2); PV_D0(3);
#undef PV_D0
#undef TRRD
}

struct BlockRef { int b, P0, qcol, kcol, vcol, ocol, kind, head; };
struct AttnBases { __amdgpu_buffer_rsrc_t prs; bf16* od; bf16* mixed; const float* cumloc; const float* ctot; const float* relt; const float* subg; float lam; };
#define BR_Q(r) ((((unsigned)((r).b * NSLAB + (r).qcol)) << 20) + (unsigned)(r).P0 * 256u)
#define BR_K(r) (((unsigned)((r).b * NSLAB + (r).kcol)) << 20)
#define BR_V(r) (((unsigned)((r).b * NSLAB + (r).vcol)) << 20)
#define BR_O(r) (((r).kind ? AB.mixed : AB.od) + ((size_t)(r).b * SKV + (r).P0) * OPITCH + (r).ocol)
#define BR_CL(r) (AB.cumloc + (size_t)((r).b * 16 + (r).head) * SKV)
#define BR_CT(r) (AB.ctot + ((r).b * 16 + (r).head) * 64)
struct Seam { bf16x8 qr[8]; };
#define VMW() asm volatile("s_waitcnt vmcnt(0)" ::: "memory")
#define FDMA(ldsoff, voffX, src) do { _Pragma("unroll") for (int j_ = 0; j_ < 2; ++j_)                                          \
        __builtin_amdgcn_raw_ptr_buffer_load_lds(AB.prs, (ATT_LAS void*)(ldsL + (ldsoff) + wid * 1024 + j_ * 8192), 16, (int)(voffX), (int)((src) + j_ * 8192), 0, 0); } while (0)
#define FDMA_K(src, bf) FDMA(2 * SHM_V + (bf) * SHM_K, voffK, src)
#define FDMA_V(src, bf) FDMA((bf) * SHM_V, voffV, src)
#define FDMA_OFFS(ln) const unsigned voffK = (unsigned)((4 * wid + ((ln) >> 4)) * 256 + ((((ln) & 15) ^ (4 * (wid & 1) + ((ln) >> 4))) * 16)),                                   \
                     voffV = (unsigned)(((((wid >> 2) * 16 + (((ln) >> 4) & 1) * 8 + ((wid >> 1) & 1) * 4 + (((ln) >> 2) & 3)) * 256) + ((((wid & 1) * 2 + ((ln) >> 5)) * 32 + ((ln) & 3) * 8) * 2)))
__device__ __forceinline__ void attn_prime(const AttnBases& AB, const BlockRef& cur, ATT_LAS unsigned char* ldsL, Seam& S, const int tid) {
    const int wid = __builtin_amdgcn_readfirstlane(tid >> 6), lane = tid & 63, r32 = lane & 31, hi = lane >> 5;
    FDMA_OFFS(lane);
    const unsigned voff_q = (unsigned)((wid * QBLK + r32) * QPITCH + hi * 8) * 2u;
    for (int d0 = 0; d0 < 8; ++d0) S.qr[d0] = bld8(AB.prs, voff_q, BR_Q(cur) + d0 * 32);
    FDMA_K(BR_K(cur), 0); FDMA_K(BR_K(cur) + (unsigned)KVBLK * 256u, 1); FDMA_V(BR_V(cur), 0); VMW();
    __syncthreads();
}
__device__ __forceinline__ void attn_tables(const AttnBases& AB, const BlockRef& cur, ATT_LAS unsigned char* ldsL, const int tid) {
    const float* relt = AB.relt; const float* cl = BR_CL(cur); const float* ct = BR_CT(cur);
    const int lane = tid & 63;
    ATT_LAS float* pre = (ATT_LAS float*)(ldsL + LDS_PRE);
    if (cur.kind == 1) {
        if (tid < 64) { const float v = ct[lane]; float s = v;
#pragma unroll
            for (int o = 1; o < 64; o <<= 1) { const float t = __shfl_up(s, o); if (lane >= o) s += t; }
            pre[lane] = s - v; }
    } else {
        if (tid < REL_N) { const int dist = REL_TOP - tid; float val = 0.f;
            if (dist >= 0) { int bk = dist;
                if (dist >= 16) { const float nf = (float)dist; int lg = 16 + (int)(logf(nf / 16.0f) / 2.0794415416798357f * 16.0f); bk = lg < 31 ? lg : 31; }
                val = (relt[bk * 8 + cur.head] - relt[31 * 8 + cur.head]) * INV_SCALE; }
            ((ATT_LAS float*)(ldsL + LDS_REL))[tid] = val; }
    }
    __syncthreads();
    if (cur.kind == 1) {
        const int k8 = tid * 8;
        if (k8 < cur.P0 + QB) {
            const float cref = pre[cur.P0 >> 6] + cl[cur.P0];
            const float pc = pre[k8 >> 6];
            const f32x4 a = *(const f32x4*)(cl + k8), b = *(const f32x4*)(cl + k8 + 4);
            ATT_LAS f32x4* dst = (ATT_LAS f32x4*)(ldsL + LDS_KB) + tid * 2;
            f32x4 o0, o1;
#pragma unroll
            for (int j = 0; j < 4; ++j) { o0[j] = (cref - (pc + a[j])) * INV_SCALE; o1[j] = (cref - (pc + b[j])) * INV_SCALE; }
            dst[0] = o0; dst[1] = o1;
        }
    }
    __syncthreads();
}
template <int BIASM, int ROLE> __device__ __forceinline__ void attn_block(const AttnBases& AB, const BlockRef& cur, const BlockRef& nxt, char* lds, ATT_LAS unsigned char* ldsL, Seam& S, const int tid) {
    const int wid = __builtin_amdgcn_readfirstlane(tid >> 6), lane = tid & 63, r32 = lane & 31, hi = lane >> 5;
    const int NT = 4 * ((cur.P0 >> 8) + 1);
    const int qlo = cur.P0 + wid * QBLK, qm = qlo + r32 - 4 * hi;
    char* V_lds = lds; char* K_lds = lds + 2 * SHM_V;
    float* ws = (float*)(lds + 2 * SHM_V + 2 * SHM_K) + wid * 64; float* li_l = ws, * al_l = ws + 32;
    float m_reg = -1e30f, l_reg = 0; f32x16 o[4] = {};
    const int vb0 = (int)(uintptr_t)V_lds + v_rd_base(lane);
    const unsigned voff_q = (unsigned)((wid * QBLK + r32) * QPITCH + hi * 8) * 2u;
    FDMA_OFFS(lane);
    const unsigned Kh = BR_K(cur), Vh = BR_V(cur);
    const int kind = cur.kind;
    const ATT_LAS float* kbL = (const ATT_LAS float*)(ldsL + LDS_KB) + 4 * hi;
    const ATT_LAS float* rlL = (const ATT_LAS float*)(ldsL + LDS_REL) + (REL_TOP - qm);
#define RESC(a) do { if (__any((a) < 1.f)) { if (hi == 0) al_l[r32] = (a); asm volatile("s_waitcnt lgkmcnt(0)" ::: "memory");              \
                     for (int d_ = 0; d_ < 4; ++d_) for (int r = 0; r < 16; ++r) o[d_][r] *= al_l[crow(r, hi)]; } } while (0)
#define KBASE(t) ((t) * KVBLK)
#define MASKT(P0_, P1_, t) do { const int kb_ = KBASE(t);                                                                      \
        if (BIASM & 1) { if (kind == 1) bias_key(P0_, P1_, kbL + kb_); }                                                      \
        if (BIASM & 2) { if (kind != 1 && kb_ > qlo - 176 && kb_ <= qlo) bias_rel(P0_, P1_, rlL + kb_); }                         \
        if (kb_ + KVBLK - 1 > qlo) mask_tile(P0_, P1_, qm - kb_); } while (0)
    f32x16 p0, p1; float mn, al; bf16x8 pa0, pa1, pa2, pa3;
#define STEP_DMA(s, SB) do { SBAR(); if ((s) + 2 < NT) FDMA_K(Kh + (unsigned)KBASE((s) + 2) * 256u, SB); FDMA_V(Vh + (unsigned)KBASE((s) + 1) * 256u, 1 - (SB)); SBAR(); } while (0)
#define LAST_DMA() do { SBAR(); FDMA_V(BR_V(nxt), 0); FDMA_K(BR_K(nxt), 0); FDMA_K(BR_K(nxt) + (unsigned)KVBLK * 256u, 1); SBAR();                \
        _Pragma("unroll") for (int d0 = 0; d0 < 8; ++d0) S.qr[d0] = bld8(AB.prs, voff_q, BR_Q(nxt) + d0 * 32); SBAR(); } while (0)
#define LV(t) (KBASE(t) <= qlo + QBLK - 1)
#define SOFTMAX(t) do { MASKT(p0, p1, (t)); partialSM(p0, p1, m_reg, mn, al); finishSM(p0, p1, al, l_reg, pa0, pa1, pa2, pa3); RESC(al); SBAR(); } while (0)
    if (ROLE == 0) {
        qkt<0>(p0, p1, K_lds, r32, hi, S.qr);
        __syncthreads();
#define STEP0(s, SB) do { STEP_DMA(s, SB); SOFTMAX(s);                                                                         \
            qkt<1 - (SB)>(p0, p1, K_lds, r32, hi, S.qr); SBAR(); pv_tile<SB>(o, vb0, pa0, pa1, pa2, pa3);                     \
            VMW(); __syncthreads(); } while (0)
#define STEP0C(s, SB) do { STEP_DMA(s, SB); if (LV(s)) SOFTMAX(s);                                                             \
            if (LV((s) + 1)) qkt<1 - (SB)>(p0, p1, K_lds, r32, hi, S.qr);                                                     \
            SBAR(); if (LV(s)) pv_tile<SB>(o, vb0, pa0, pa1, pa2, pa3);                                                       \
            VMW(); __syncthreads(); } while (0)
        for (int s = 0; s + 4 < NT; s += 2) { STEP0(s, 0); STEP0(s + 1, 1); }
        STEP0C(NT - 4, 0); STEP0C(NT - 3, 1); STEP0C(NT - 2, 0);
        LAST_DMA();
        if (LV(NT - 1)) { SOFTMAX(NT - 1);
            pv_tile<1>(o, vb0, pa0, pa1, pa2, pa3); }
#undef STEP0
#undef STEP0C
    } else {
        qkt<0>(p0, p1, K_lds, r32, hi, S.qr);
        SOFTMAX(0);
        __syncthreads();
#define STEP1(s, SB) do { STEP_DMA(s, SB);                                                                                     \
            qkt<1 - (SB)>(p0, p1, K_lds, r32, hi, S.qr); SBAR(); pv_tile<SB>(o, vb0, pa0, pa1, pa2, pa3);                     \
            SOFTMAX((s) + 1);                                                                                                 \
            VMW(); __syncthreads(); } while (0)
#define STEP1C(s, SB) do { STEP_DMA(s, SB);                                                                                    \
            if (LV((s) + 1)) qkt<1 - (SB)>(p0, p1, K_lds, r32, hi, S.qr);                                                     \
            SBAR(); if (LV(s)) pv_tile<SB>(o, vb0, pa0, pa1, pa2, pa3);                                                       \
            if (LV((s) + 1)) SOFTMAX((s) + 1);                                                                                \
            VMW(); __syncthreads(); } while (0)
        for (int s = 0; s + 4 < NT; s += 2) { STEP1(s, 0); STEP1(s + 1, 1); }
        STEP1C(NT - 4, 0); STEP1C(NT - 3, 1); STEP1C(NT - 2, 0);
        LAST_DMA();
        if (LV(NT - 1)) pv_tile<1>(o, vb0, pa0, pa1, pa2, pa3);
#undef STEP1
#undef STEP1C
    }
    SBAR();
#undef STEP_DMA
#undef LAST_DMA
#undef SOFTMAX
#undef LV
    if (hi == 0) li_l[r32] = l_reg; asm volatile("s_waitcnt lgkmcnt(0)" ::: "memory");
    float rli[16];
#pragma unroll
    for (int r = 0; r < 16; ++r) rli[r] = __builtin_amdgcn_rcpf(li_l[crow(r, hi)]);
    bf16* Ow = BR_O(cur) + (size_t)(wid * QBLK) * OPITCH;
    ATT_LAS unsigned char* ost = ldsL + LDS_OST + wid * OST_WAVE;
    int ln = lane; asm volatile("" : "+v"(ln));
    const int wr_off = (4 * (ln >> 5)) * OST_ROW + (ln & 31) * 2, rd_off = (ln >> 4) * OST_ROW + (ln & 15) * 16;
    const unsigned voff_o = (unsigned)((ln >> 4) * OPITCH + (ln & 15) * 8);
#pragma unroll
    for (int p = 0; p < 2; ++p) {
#pragma unroll
        for (int rr = 0; rr < 8; ++rr) { const int r = 8 * p + rr, row0 = (rr & 3) + 8 * (rr >> 2);
#pragma unroll
            for (int d0 = 0; d0 < 4; d0 += 2) { const unsigned w = cvtpk(o[d0][r] * rli[r], o[d0 + 1][r] * rli[r]);
                *(ATT_LAS unsigned short*)(ost + wr_off + row0 * OST_ROW + d0 * 64) = (unsigned short)(w & 0xffffu);
                *(ATT_LAS unsigned short*)(ost + wr_off + row0 * OST_ROW + (d0 + 1) * 64) = (unsigned short)(w >> 16); } }
        asm volatile("s_waitcnt lgkmcnt(0)" ::: "memory");
        u32x4 ch[4];
#pragma unroll
        for (int j = 0; j < 4; ++j) ch[j] = *(const ATT_LAS u32x4*)(ost + rd_off + (4 * j) * OST_ROW);
        asm volatile("s_waitcnt lgkmcnt(0)" ::: "memory");
#pragma unroll
        for (int j = 0; j < 4; ++j) *(u32x4*)(Ow + (size_t)(16 * p + 4 * j) * OPITCH + voff_o) = ch[j];
    }
    VMW(); __syncthreads();
#undef RESC
#undef KBASE
#undef MASKT
}
constexpr int D2_K = 0, D2_VA = 32768, D2_VB = 65536, D2_P = 98304, D2_PSLOT = 4352, D2_LI = D2_P + 8 * D2_PSLOT, D2_WS = D2_LI + 512, D2_REL = D2_WS + 1024, D2_SS = D2_REL + 2048  , D2_BYTES = D2_SS + 1024;
constexpr int D2_QB = 128;
struct Ref2 { int b, P0, qcol, kcol, vcol, head, m; };
__device__ __forceinline__ void diff_block(const AttnBases& AB, const Ref2& R, char* lds, ATT_LAS unsigned char* ldsL, const int tid) {
    const int wid = __builtin_amdgcn_readfirstlane(tid >> 6), lane = tid & 63, r32 = lane & 31, hi = lane >> 5;
    const bool isA = wid < 4; const int g = wid & 3;
    const int NT = 2 * ((R.P0 >> 7) + 1);
    const unsigned Qb = (((unsigned)(R.b * NSLAB + R.qcol)) << 20) + (unsigned)R.P0 * 256u;
    const unsigned Kh = ((unsigned)(R.b * NSLAB + R.kcol)) << 20;
    const unsigned Vh = ((unsigned)(R.b * NSLAB + R.vcol)) << 20;
    const int qlo = R.P0 + g * QBLK, qm = qlo + r32 - 4 * hi;
    char* K_lds = lds + D2_K;
    const int vbA = (int)(uintptr_t)(lds + D2_VA) + v_rd_base(lane), vbB = (int)(uintptr_t)(lds + D2_VB) + v_rd_base(lane);
    ATT_LAS float* al_l = (ATT_LAS float*)(ldsL + D2_WS) + g * 64;
    ATT_LAS float* liS = (ATT_LAS float*)(ldsL + D2_LI) + g * 32;
    const ATT_LAS float* rlL = (const ATT_LAS float*)(ldsL + D2_REL) + (REL_TOP - qm);
    const int wb = wid & 3;
    f32x16 o[4] = {};
#define D2_BAR() do { asm volatile("s_waitcnt lgkmcnt(0)" ::: "memory"); __builtin_amdgcn_s_barrier(); asm volatile("" ::: "memory"); } while (0)
#define VMW() asm volatile("s_waitcnt vmcnt(0)" ::: "memory")
#define KBASE(t) ((t) * KVBLK)
#define PSLOT(buf) (ldsL + D2_P + (g * 2 + (buf)) * D2_PSLOT)
#define DMA_TILE(ldsoff, voffX, src) do { _Pragma("unroll") for (int j_ = 0; j_ < 4; ++j_)                                    \
        __builtin_amdgcn_raw_ptr_buffer_load_lds(AB.prs, (ATT_LAS void*)(ldsL + (ldsoff) + wb * 1024 + j_ * 4096), 16, (int)(voffX), (int)((src) + j_ * 4096), 0, 0); } while (0)
#define DMA_K(t, bf)  DMA_TILE(D2_K + (bf) * SHM_K, voffK, Kh + (unsigned)KBASE(t) * 256u)
#define DMA_VA(t, bf) DMA_TILE(D2_VA + (bf) * SHM_V, voffV, Vh + (unsigned)KBASE(t) * 256u)
#define DMA_VB(t, bf) DMA_TILE(D2_VB + (bf) * SHM_V, voffV, Vh + (1u << 20) + (unsigned)KBASE(t) * 256u)
#define RESC(a) do { if (__any((a) < 1.f)) { if (hi == 0) al_l[r32] = (a); asm volatile("s_waitcnt lgkmcnt(0)" ::: "memory");              \
                     for (int d_ = 0; d_ < 4; ++d_) for (int r = 0; r < 16; ++r) o[d_][r] *= al_l[crow(r, hi)]; } } while (0)
#define MASKT(P0_, P1_, t) do { const int kb_ = KBASE(t);                                                                      \
        if (kb_ > qlo - 176 && kb_ <= qlo) bias_rel(P0_, P1_, rlL + kb_);                                                      \
        if (kb_ + KVBLK - 1 > qlo) mask_tile(P0_, P1_, qm - kb_); } while (0)
#define P_PUT(buf, alY) do { ATT_LAS unsigned char* s_ = PSLOT(buf);                                                            \
        *(ATT_LAS bf16x8*)(s_ + lane * 16) = pa0; *(ATT_LAS bf16x8*)(s_ + 1024 + lane * 16) = pa1;                            \
        *(ATT_LAS bf16x8*)(s_ + 2048 + lane * 16) = pa2; *(ATT_LAS bf16x8*)(s_ + 3072 + lane * 16) = pa3;                     \
        if (hi == 0) *(ATT_LAS float*)(s_ + 4096 + r32 * 4) = (alY);                                                          \
        const int any_ = __any((alY) < 1.f) ? 1 : 0; if (lane == 0) *(ATT_LAS int*)(s_ + 4224) = any_; } while (0)
#define P_GET_PV(buf) do { const ATT_LAS unsigned char* s_ = PSLOT(buf);                                                       \
        pa0 = *(const ATT_LAS bf16x8*)(s_ + lane * 16); pa1 = *(const ATT_LAS bf16x8*)(s_ + 1024 + lane * 16);               \
        pa2 = *(const ATT_LAS bf16x8*)(s_ + 2048 + lane * 16); pa3 = *(const ATT_LAS bf16x8*)(s_ + 3072 + lane * 16);        \
        const int any_ = __builtin_amdgcn_readfirstlane(*(const ATT_LAS int*)(s_ + 4224));                                    \
        if (any_) { _Pragma("unroll") for (int gq = 0; gq < 4; ++gq) { const f32x4 a_ = *(const ATT_LAS f32x4*)(s_ + 4096 + (8 * gq + 4 * hi) * 4);       \
                _Pragma("unroll") for (int d_ = 0; d_ < 4; ++d_) _Pragma("unroll") for (int j_ = 0; j_ < 4; ++j_) o[d_][4 * gq + j_] *= a_[j_]; } }     \
        asm volatile("s_waitcnt lgkmcnt(0)" ::: "memory"); SBAR();                                                            \
        pv_tile<buf>(o, vbB, pa0, pa1, pa2, pa3); } while (0)
    if (tid < REL_N) { const int dist = REL_TOP - tid; float val = 0.f;
        if (dist >= 0) { int bk = dist;
            if (dist >= 16) { const float nf = (float)dist; int lg = 16 + (int)(logf(nf / 16.0f) / 2.0794415416798357f * 16.0f); bk = lg < 31 ? lg : 31; }
            val = (AB.relt[bk * 8 + R.head] - AB.relt[31 * 8 + R.head]) * INV_SCALE; }
        ((ATT_LAS float*)(ldsL + D2_REL))[tid] = val; }
    if (isA) {
        float m_reg = -1e30f, l_reg = 0.f; bf16x8 qr[8];
        f32x16 pA0, pA1, pB0, pB1; float mnA, mnB, alA = 1.f, alB = 1.f; bf16x8 pa0, pa1, pa2, pa3;
#pragma unroll
        for (int d0 = 0; d0 < 8; ++d0) qr[d0] = bld8(AB.prs, (unsigned)((g * QBLK + r32) * QPITCH + hi * 8) * 2u, Qb + d0 * 32);
        D2_BAR();
        SBAR(); qkt<0>(pA0, pA1, K_lds, r32, hi, qr); MASKT(pA0, pA1, 0); partialSM(pA0, pA1, m_reg, mnA, alA);
        D2_BAR();
#define STEP_A(PX0, PX1, mnX, alX, PY0, PY1, alY, t, KB, PVB) do {                                                             \
            SBAR(); qkt<KB>(PX0, PX1, K_lds, r32, hi, qr);                                                                    \
            finishSM(PY0, PY1, alY, l_reg, pa0, pa1, pa2, pa3); SBAR();                                                       \
            P_PUT(PVB, alY);                                                                                                  \
            pv_tile<PVB>(o, vbA, pa0, pa1, pa2, pa3); MASKT(PX0, PX1, (t)); partialSM(PX0, PX1, m_reg, mnX, alX);             \
            RESC(alX); D2_BAR(); } while (0)
        for (int t = 1; t + 1 < NT; t += 2) {
            STEP_A(pB0, pB1, mnB, alB, pA0, pA1, alA, t, 1, 0);
            STEP_A(pA0, pA1, mnA, alA, pB0, pB1, alB, t + 1, 0, 1);
        }
        const bool lvL = KBASE(NT - 1) <= qlo + QBLK - 1;
        SBAR(); if (lvL) qkt<1>(pB0, pB1, K_lds, r32, hi, qr);
        finishSM(pA0, pA1, alA, l_reg, pa0, pa1, pa2, pa3); SBAR();
        P_PUT(0, alA);
        pv_tile<0>(o, vbA, pa0, pa1, pa2, pa3);
        if (lvL) { MASKT(pB0, pB1, NT - 1); partialSM(pB0, pB1, m_reg, mnB, alB); RESC(alB); }
        D2_BAR();
        if (lvL) { finishSM(pB0, pB1, alB, l_reg, pa0, pa1, pa2, pa3); SBAR(); P_PUT(1, alB); pv_tile<1>(o, vbA, pa0, pa1, pa2, pa3); }
        if (hi == 0) liS[r32] = l_reg;
        D2_BAR();
#undef STEP_A
    } else {
        bf16x8 pa0, pa1, pa2, pa3;
        int lb = lane; asm volatile("" : "+v"(lb));
        const unsigned voffK = (unsigned)((4 * wb + (lb >> 4)) * 256 + (((lb & 15) ^ (4 * (wb & 1) + (lb >> 4))) * 16));
        const unsigned voffV = (unsigned)(((((lb >> 4) & 1) * 8 + ((wb >> 1) & 1) * 4 + ((lb >> 2) & 3)) * 256) + ((((wb & 1) * 2 + (lb >> 5)) * 32 + (lb & 3) * 8) * 2));
        DMA_K(0, 0); VMW();
        D2_BAR();
        DMA_K(1, 1); DMA_VA(0, 0); VMW();
        D2_BAR();
#define STEP_B(t, KB, PVB) do {                                                                                                \
            if ((t) + 1 < NT) DMA_K((t) + 1, PVB); DMA_VA(t, KB); DMA_VB((t) - 1, PVB); SBAR();                               \
            if ((t) >= 2) P_GET_PV(KB);                                                                                       \
            VMW(); D2_BAR(); } while (0)
        for (int t = 1; t + 1 < NT; t += 2) { STEP_B(t, 1, 0); STEP_B(t + 1, 0, 1); }
        STEP_B(NT - 1, 1, 0);
        DMA_VB(NT - 1, 1);
        P_GET_PV(0);
        VMW(); D2_BAR();
        if (KBASE(NT - 1) <= qlo + QBLK - 1) P_GET_PV(1);
#undef STEP_B
    }
    {   float rli[16];
#pragma unroll
        for (int r = 0; r < 16; ++r) rli[r] = __builtin_amdgcn_rcpf(liS[crow(r, hi)]);
        const int hfw = isA ? 0 : 1;
        bf16* O1w = AB.od + ((size_t)R.b * SKV + R.P0 + g * QBLK) * OPITCH + R.head * 512 + hfw * 128;
        bf16* Mw = AB.mixed + ((size_t)R.b * SKV + R.P0 + g * QBLK) * OPITCH + R.head * 256 + hfw * 128;
        ATT_LAS unsigned char* ost = ldsL + (isA ? D2_K : D2_VA) + g * OST_WAVE;
        int ln = lane; asm volatile("" : "+v"(ln));
        const int wr_off = (4 * (ln >> 5)) * OST_ROW + (ln & 31) * 2, rd_off = (ln >> 4) * OST_ROW + (ln & 15) * 16;
        const unsigned voff_o = (unsigned)((ln >> 4) * OPITCH + (ln & 15) * 8);
#define D2_STAGE(p) do { _Pragma("unroll") for (int rr = 0; rr < 8; ++rr) { const int r = 8 * (p) + rr, row0 = (rr & 3) + 8 * (rr >> 2);                                   \
            _Pragma("unroll") for (int d0 = 0; d0 < 4; d0 += 2) { const unsigned w = cvtpk(o[d0][r] * rli[r], o[d0 + 1][r] * rli[r]);                                        \
                *(ATT_LAS unsigned short*)(ost + wr_off + row0 * OST_ROW + d0 * 64) = (unsigned short)(w & 0xffffu);                                                        \
                *(ATT_LAS unsigned short*)(ost + wr_off + row0 * OST_ROW + (d0 + 1) * 64) = (unsigned short)(w >> 16); } }                                                  \
        asm volatile("s_waitcnt lgkmcnt(0)" ::: "memory");                                                                                                                  \
        _Pragma("unroll") for (int j = 0; j < 4; ++j) ch[j] = *(const ATT_LAS u32x4*)(ost + rd_off + (4 * j) * OST_ROW);                                                    \
        asm volatile("s_waitcnt lgkmcnt(0)" ::: "memory"); } while (0)
        if (R.m == 0) {
#pragma unroll
            for (int p = 0; p < 2; ++p) { u32x4 ch[4]; D2_STAGE(p);
#pragma unroll
                for (int j = 0; j < 4; ++j) *(u32x4*)(O1w + (size_t)(16 * p + 4 * j) * OPITCH + voff_o) = ch[j]; }
            asm volatile("s_waitcnt vmcnt(0)" ::: "memory");
        } else {
            const f32x4 gm0 = *(const f32x4*)(AB.subg + hfw * 128 + (ln & 15) * 8), gm1 = *(const f32x4*)(AB.subg + hfw * 128 + (ln & 15) * 8 + 4);
            ATT_LAS float* ssMine = (ATT_LAS float*)(ldsL + D2_SS) + (hfw * 4 + g) * 32;
            const ATT_LAS float* ssPeer = (const ATT_LAS float*)(ldsL + D2_SS) + ((1 - hfw) * 4 + g) * 32;
            float dv[2][4][8], ssr[2][4];
#pragma unroll
            for (int p = 0; p < 2; ++p) { u32x4 ch[4], q1[4];
#pragma unroll
                for (int j = 0; j < 4; ++j) q1[j] = *(const u32x4*)(O1w + (size_t)(16 * p + 4 * j) * OPITCH + voff_o);
                D2_STAGE(p);
#pragma unroll
                for (int j = 0; j < 4; ++j) { float ss = 0.f;
#pragma unroll
                    for (int e = 0; e < 4; ++e) { const unsigned a = q1[j][e], b = ch[j][e];
                        const float d0_ = __uint_as_float(a << 16) - AB.lam * __uint_as_float(b << 16), d1_ = __uint_as_float(a & 0xffff0000u) - AB.lam * __uint_as_float(b & 0xffff0000u);
                        dv[p][j][2 * e] = d0_; dv[p][j][2 * e + 1] = d1_; ss += d0_ * d0_ + d1_ * d1_; }
                    ss += __shfl_xor(ss, 1); ss += __shfl_xor(ss, 2); ss += __shfl_xor(ss, 4); ss += __shfl_xor(ss, 8);
                    ssr[p][j] = ss;
                    if ((ln & 15) == 0) ssMine[16 * p + 4 * j + (ln >> 4)] = ss; } }
            D2_BAR();
#pragma unroll
            for (int p = 0; p < 2; ++p)
#pragma unroll
                for (int j = 0; j < 4; ++j) { const float tot = ssr[p][j] + ssPeer[16 * p + 4 * j + (ln >> 4)];
                    const float rs = 0.8f / sqrtf(tot * (1.0f / 256.0f) + 1e-6f);
                    u32x4 w;
                    w.x = cvtpk(dv[p][j][0] * rs * gm0[0], dv[p][j][1] * rs * gm0[1]); w.y = cvtpk(dv[p][j][2] * rs * gm0[2], dv[p][j][3] * rs * gm0[3]);
                    w.z = cvtpk(dv[p][j][4] * rs * gm1[0], dv[p][j][5] * rs * gm1[1]); w.w = cvtpk(dv[p][j][6] * rs * gm1[2], dv[p][j][7] * rs * gm1[3]);
                    *(u32x4*)(Mw + (size_t)(16 * p + 4 * j) * OPITCH + voff_o) = w; }
        }
#undef D2_STAGE
    }
    D2_BAR();
#undef D2_BAR
#undef VMW
#undef KBASE
#undef PSLOT
#undef DMA_TILE
#undef DMA_K
#undef DMA_VA
#undef DMA_VB
#undef RESC
#undef MASKT
#undef P_PUT
#undef P_GET_PV
}
#undef BR_Q
#undef BR_K
#undef BR_V
#undef BR_O
#undef BR_CL
#undef BR_CT
#undef VMW
#undef FDMA
#undef FDMA_K
#undef FDMA_V
#undef FDMA_OFFS
constexpr int LDS_BYTES = D2_BYTES > LDS_BYTES_FOX ? D2_BYTES : LDS_BYTES_FOX;
}

constexpr int NWAVES = 8;
constexpr int BATCH = 4, SEQ = 4096, DM = 4096, M = BATCH * SEQ;
constexpr int NQKV = 12288, INCOLS = 12304, NFH = 16, DFF = 11008, NGU = 2 * DFF;
constexpr float EPS = 1e-6f;

constexpr size_t MiB = 1u << 20;
constexpr size_t WS_CTL = 0, CTL_ZERO_BYTES = 1 * MiB;
constexpr size_t WS_CUMLOC = 1 * MiB;
constexpr size_t WS_CTOT = 2 * MiB;
constexpr size_t WS_WFT = 3 * MiB;
constexpr size_t WS_WIN = 8 * MiB;
constexpr size_t WS_WO = 104 * MiB;
constexpr size_t WS_WGU = 136 * MiB;
constexpr size_t WS_WD = 308 * MiB;
constexpr size_t WS_A = 394 * MiB;
constexpr size_t WS_B = 522 * MiB;
constexpr size_t WS_XB = WS_B + 344 * MiB;
constexpr size_t WS_END = 994 * MiB;
static_assert(WS_WIN + (size_t)NQKV * DM * 2 <= WS_WO && WS_WO + (size_t)DM * DM * 2 <= WS_WGU && WS_WGU + (size_t)NGU * DM * 2 <= WS_WD && WS_WD + (size_t)DM * DFF * 2 <= WS_A
              && WS_A + (size_t)M * DM * 2 <= WS_B && WS_B + (size_t)M * NQKV * 2 <= WS_END && WS_B + (size_t)M * DFF * 2 <= WS_XB && WS_XB + (size_t)M * DM * 2 <= WS_END, "d_ws map");
constexpr int CW_TMO = 0, CW_CODE = 1;
constexpr int CW_BAR = 4096;
constexpr int CW_ROWSS = 65536;
static_assert((CW_ROWSS + 2 * M) * 4 <= (int)CTL_ZERO_BYTES, "CTL words (rowss, then rms of the input rows) inside the memset region");

constexpr int RING_OFF = 0, RING_BYTES = 131072;
constexpr int LDSCTL_OFF = 139264, MISC_OFF = LDSCTL_OFF + 320;
constexpr int LDS_BYTES = 147456;
static_assert(MISC_OFF + 128 <= LDS_BYTES && att::LDS_BYTES <= LDSCTL_OFF && RING_BYTES <= LDSCTL_OFF, "LDS map");

#define GAS __attribute__((address_space(1)))
#define LAS __attribute__((address_space(3)))
typedef unsigned short bf16;
typedef unsigned v4u __attribute__((ext_vector_type(4)));
typedef float f32x4 __attribute__((ext_vector_type(4)));
typedef short bf16x8 __attribute__((ext_vector_type(8)));
typedef GAS unsigned gu32;
#define RLX_AGENT __ATOMIC_RELAXED, __HIP_MEMORY_SCOPE_AGENT
#define LDS_WAIT() asm volatile("s_waitcnt lgkmcnt(0)" ::: "memory")
#define VM_WAIT() asm volatile("s_waitcnt vmcnt(0)" ::: "memory")
__device__ __forceinline__ unsigned f2bf(float f) { unsigned u = __builtin_bit_cast(unsigned, f); return (u + 0x7fffu + ((u >> 16) & 1u)) >> 16; }
__device__ __forceinline__ unsigned pk2(float lo, float hi) { return f2bf(lo) | (f2bf(hi) << 16); }
__device__ __forceinline__ float bf2f(short s) { return __builtin_bit_cast(float, ((unsigned)(unsigned short)s) << 16); }

#define XB_TMO      128
#define XB_XCNT(j)  (256  + 64 * (j))
#define XB_XSUB(j)  (1280 + 64 * (j))
#define XB_XGEN(j)  (2304 + 64 * (j))
#define XB_TOP      3328
#define XB_TOPGEN   3392
#define XCD_BAR_WORDS 3456
#define XB_SPIN_CAP (1u << 18)

__device__ __forceinline__ unsigned xb_ld(unsigned* p)              { return __hip_atomic_load(p, __ATOMIC_RELAXED, __HIP_MEMORY_SCOPE_AGENT); }
__device__ __forceinline__ unsigned xb_add(unsigned* p, unsigned v) { return __hip_atomic_fetch_add(p, v, __ATOMIC_RELAXED, __HIP_MEMORY_SCOPE_AGENT); }
__device__ __forceinline__ unsigned xb_xcc_id() { return (unsigned)__builtin_amdgcn_s_getreg((3 << 11) | 20) & 0xFu; }
#define XB_SPIN(cond, bar) do { unsigned _sp = 0; while (cond) { __builtin_amdgcn_s_sleep(1); \
    if ((++_sp & 255u) == 0u) { if (xb_ld(&(bar)[XB_TMO])) break; if (_sp > XB_SPIN_CAP) { atomicAdd(&(bar)[XB_TMO], 1u); break; } } } } while (0)

struct XcdBarrier {
    unsigned* bar; unsigned x;
    volatile LAS unsigned* st;
};

__device__ __forceinline__ XcdBarrier xcd_barrier_post(unsigned* bar, volatile LAS unsigned* st) {
    XcdBarrier b; b.bar = bar; b.x = xb_xcc_id(); b.st = st;
    if (threadIdx.x == 0) (void)xb_add(&bar[XB_XCNT(b.x)], 1u);
    return b;
}
__device__ __forceinline__ void xcd_barrier_complete(unsigned* bar, unsigned x, unsigned& nloc, unsigned& nx) {
    const unsigned G = gridDim.x * gridDim.y * gridDim.z;
    unsigned sum, cnt, mine, sp = 0u;
    for (;;) {
        sum = 0u; cnt = 0u; mine = 0u;
#pragma unroll
        for (unsigned j = 0; j < 16; ++j) { const unsigned c = xb_ld(&bar[XB_XCNT(j)]); sum += c; cnt += (c > 0u) ? 1u : 0u; mine = (j == x) ? c : mine; }
        if (sum == G) break;
        __builtin_amdgcn_s_sleep(1);
        if ((++sp & 255u) == 0u) { if (xb_ld(&bar[XB_TMO])) break; if (sp > XB_SPIN_CAP) { atomicAdd(&bar[XB_TMO], 1u); break; } }
    }
    nloc = mine > 0u ? mine : 1u; nx = cnt > 0u ? cnt : 1u;
}

__device__ __forceinline__ void xcd_barrier(const XcdBarrier& b) {
    asm volatile("s_waitcnt vmcnt(0)" ::: "memory");
    __syncthreads();
    if (threadIdx.x == 0) {
        unsigned* bar = b.bar;
        __builtin_amdgcn_s_waitcnt(0);
        unsigned nloc = b.st[0], nx = b.st[1];
        if (nloc == 0u) { xcd_barrier_complete(bar, b.x, nloc, nx); b.st[0] = nloc; b.st[1] = nx; }
        const unsigned old = xb_add(&bar[XB_XSUB(b.x)], 1u);
        const unsigned gen = old / nloc;
        if (old + 1u == (gen + 1u) * nloc) {
            __builtin_amdgcn_fence(__ATOMIC_RELEASE, "agent");
            asm volatile("s_waitcnt vmcnt(0)" ::: "memory");
            const unsigned og = xb_add(&bar[XB_TOP], 1u);
            const unsigned tg = og / nx;
            if (og + 1u == (tg + 1u) * nx) xb_add(&bar[XB_TOPGEN], 1u);
            else XB_SPIN(xb_ld(&bar[XB_TOPGEN]) == tg, bar);
            __builtin_amdgcn_fence(__ATOMIC_ACQUIRE, "agent");
            xb_add(&bar[XB_XGEN(b.x)], 1u);
            asm volatile("s_waitcnt vmcnt(0)" ::: "memory");
        } else {
            XB_SPIN(xb_ld(&bar[XB_XGEN(b.x)]) == gen, bar);
            __builtin_amdgcn_fence(__ATOMIC_ACQUIRE, "agent");
            asm volatile("s_waitcnt vmcnt(0)" ::: "memory");
        }
    }
    __syncthreads();
}

struct Frame {
    LAS unsigned char* lds;
    volatile LAS unsigned* MISC;
    gu32* ctl;
    int tid, lane, wave;
    int vcu, G;
    const float *x, *g_attn, *w_in, *b_f, *lq1, *lk1, *lq2, *lk2, *relt, *subg, *w_o, *g_ffn, *w_gate, *w_up, *w_down, *g_final;
    float* out;
    bf16 *Win_t, *WfT, *Wo_t, *Wgu_t, *Wd_t, *bufA, *bufB, *od, *xb, *mx;
    float* rinv;
    float *cumloc, *ctot;
};
__device__ __forceinline__ float wave_sum(float v) {
    const int ln = pg8::fresh_lane();
#pragma unroll
    for (int o = 1; o < 64; o <<= 1) v += __builtin_bit_cast(float, __builtin_amdgcn_ds_bpermute((ln ^ o) << 2, __builtin_bit_cast(int, v)));
    return v;
}
template <bool GAIN> __device__ __forceinline__ void transpose_item(const float* W, int ldw, int k0, int n0, bf16* WT, int Kdst, int drow0, LAS float* scr, int lane, const float* gk = nullptr) {
#pragma unroll 8
    for (int i = 0; i < 32; ++i) { const int kk = 2 * i + (lane >> 5); float v = W[(size_t)(k0 + kk) * ldw + n0 + (lane & 31)]; if (GAIN) v *= gk[k0 + kk]; scr[kk * 33 + (lane & 31)] = v; }
    LDS_WAIT(); asm volatile("" ::: "memory");
    const int c = lane & 7;
#pragma unroll
    for (int j = 0; j < 4; ++j) { const int n = (lane >> 3) + 8 * j; const LAS float* s = scr + (8 * c) * 33 + n;
        v4u o; o.x = pk2(s[0 * 33], s[1 * 33]); o.y = pk2(s[2 * 33], s[3 * 33]); o.z = pk2(s[4 * 33], s[5 * 33]); o.w = pk2(s[6 * 33], s[7 * 33]);
        *(GAS v4u*)(WT + (size_t)(drow0 + n) * Kdst + k0 + 8 * c) = o; }
    LDS_WAIT(); asm volatile("" ::: "memory");
}
template <bool OUT_BF16> __device__ __forceinline__ void norm_rows(Frame& F, const float* X, const float* g, void* out, bool bad) {
    const int tid = pg8::fresh_tid(F.wave), lane = tid & 63, wave = __builtin_amdgcn_readfirstlane(tid >> 6);
    const int gw = F.vcu * NWAVES + wave, NGW = F.G * NWAVES;
    f32x4 gv[16];
#pragma unroll
    for (int j = 0; j < 16; ++j) gv[j] = ((const GAS f32x4*)g)[lane + 64 * j];
    for (int m = gw; m < M; m += NGW) {
        const GAS f32x4* xr = (const GAS f32x4*)(X + (size_t)m * DM) + lane;
        f32x4 v[16]; float s = 0.f;
#pragma unroll
        for (int j = 0; j < 16; ++j) { v[j] = xr[64 * j]; s += (v[j].x * v[j].x + v[j].y * v[j].y) + (v[j].z * v[j].z + v[j].w * v[j].w); }
        float r = 1.0f / sqrtf(wave_sum(s) * (1.0f / DM) + EPS);
        if (bad) r = __builtin_nanf("");
        if (OUT_BF16) { GAS unsigned long long* o8 = (GAS unsigned long long*)((bf16*)out + (size_t)m * DM) + lane;
#pragma unroll
            for (int j = 0; j < 16; ++j) o8[64 * j] = (unsigned long long)pk2(v[j].x * r * gv[j].x, v[j].y * r * gv[j].y) | ((unsigned long long)pk2(v[j].z * r * gv[j].z, v[j].w * r * gv[j].w) << 32);
        } else { GAS f32x4* o = (GAS f32x4*)((float*)out + (size_t)m * DM) + lane;
#pragma unroll
            for (int j = 0; j < 16; ++j) o[64 * j] = (v[j] * r) * gv[j]; }
    }
}
__device__ __forceinline__ void rows_to_bf16(Frame& F, const float* X, bf16* out, float* rinv) {
    const int tid = pg8::fresh_tid(F.wave), lane = tid & 63, wave = __builtin_amdgcn_readfirstlane(tid >> 6);
    const int gw = F.vcu * NWAVES + wave, NGW = F.G * NWAVES;
    for (int m = gw; m < M; m += NGW) {
        const GAS f32x4* xr = (const GAS f32x4*)(X + (size_t)m * DM) + lane;
        f32x4 v[16]; float s = 0.f;
#pragma unroll
        for (int j = 0; j < 16; ++j) { v[j] = xr[64 * j]; s += (v[j].x * v[j].x + v[j].y * v[j].y) + (v[j].z * v[j].z + v[j].w * v[j].w); }
        const float r = 1.0f / sqrtf(wave_sum(s) * (1.0f / DM) + EPS);
        if (lane == 0) rinv[m] = r;
        GAS unsigned long long* o8 = (GAS unsigned long long*)(out + (size_t)m * DM) + lane;
#pragma unroll
        for (int j = 0; j < 16; ++j) o8[64 * j] = (unsigned long long)pk2(v[j].x, v[j].y) | ((unsigned long long)pk2(v[j].z, v[j].w) << 32);
    }
}
__device__ __forceinline__ void norm_rows_bf16in(Frame& F, const bf16* X, const float* g, float* out, bool bad) {
    const int tid = pg8::fresh_tid(F.wave), lane = tid & 63, wave = __builtin_amdgcn_readfirstlane(tid >> 6);
    const int gw = F.vcu * NWAVES + wave, NGW = F.G * NWAVES;
    f32x4 gv[16];
#pragma unroll
    for (int j = 0; j < 8; ++j) { gv[2 * j] = ((const GAS f32x4*)g)[2 * (lane + 64 * j)]; gv[2 * j + 1] = ((const GAS f32x4*)g)[2 * (lane + 64 * j) + 1]; }
    for (int m = gw; m < M; m += NGW) {
        const GAS v4u* xr = (const GAS v4u*)(X + (size_t)m * DM) + lane;
        f32x4 v[16]; float s = 0.f;
#pragma unroll
        for (int j = 0; j < 8; ++j) { const v4u w = xr[64 * j];
            v[2 * j] = (f32x4){__uint_as_float(w.x << 16), __uint_as_float(w.x & 0xffff0000u), __uint_as_float(w.y << 16), __uint_as_float(w.y & 0xffff0000u)};
            v[2 * j + 1] = (f32x4){__uint_as_float(w.z << 16), __uint_as_float(w.z & 0xffff0000u), __uint_as_float(w.w << 16), __uint_as_float(w.w & 0xffff0000u)}; }
#pragma unroll
        for (int j = 0; j < 16; ++j) s += (v[j].x * v[j].x + v[j].y * v[j].y) + (v[j].z * v[j].z + v[j].w * v[j].w);
        float r = 1.0f / sqrtf(wave_sum(s) * (1.0f / DM) + EPS);
        if (bad) r = __builtin_nanf("");
        GAS f32x4* o = (GAS f32x4*)(out + (size_t)m * DM) + 2 * lane;
#pragma unroll
        for (int j = 0; j < 8; ++j) { o[128 * j] = (v[2 * j] * r) * gv[2 * j]; o[128 * j + 1] = (v[2 * j + 1] * r) * gv[2 * j + 1]; }
    }
}
__device__ __forceinline__ void p0_prologue(Frame& F) {
    const int tid = pg8::fresh_tid(F.wave), lane = tid & 63, wave = __builtin_amdgcn_readfirstlane(tid >> 6);
    LAS float* scr = (LAS float*)(F.lds + RING_OFF + wave * 16384);
    const int gw = F.vcu * NWAVES + wave, NGW = F.G * NWAVES;
    constexpr int KB4 = DM / 64, KBF = DFF / 64;
    constexpr int I_IN = KB4 * (NQKV / 32), I_O = KB4 * (DM / 32), I_G = KB4 * (DFF / 32), I_D = KBF * (DM / 32);
    constexpr int NITEMS = I_IN + I_O + 2 * I_G;
    for (int it = gw; it < NITEMS; it += NGW) {
        int r = it;
        if (r < I_IN) { const int nblk = NQKV / 32, kb = r / nblk, nb = r % nblk; transpose_item<true>(F.w_in, INCOLS, 64 * kb, 32 * nb, F.Win_t, DM, 32 * nb, scr, lane, F.g_attn); continue; } r -= I_IN;
        if (r < I_O) { const int nblk = DM / 32, kb = r / nblk, nb = r % nblk; transpose_item<false>(F.w_o, DM, 64 * kb, 32 * nb, F.Wo_t, DM, 32 * nb, scr, lane); continue; } r -= I_O;
        if (r < I_G) { const int nblk = DFF / 32, kb = r / nblk, nb = r % nblk, n0 = 32 * nb; transpose_item<true>(F.w_gate, DFF, 64 * kb, n0, F.Wgu_t, DM, (n0 >> 7) * 256 + (n0 & 127), scr, lane, F.g_ffn); continue; } r -= I_G;
        { const int nblk = DFF / 32, kb = r / nblk, nb = r % nblk, n0 = 32 * nb; transpose_item<true>(F.w_up, DFF, 64 * kb, n0, F.Wgu_t, DM, (n0 >> 7) * 256 + 128 + (n0 & 127), scr, lane, F.g_ffn); }
    }
    for (int i = gw * 64 + lane; i < NFH * DM; i += NGW * 64) { const int n = i / DM, k = i % DM; F.WfT[i] = (bf16)f2bf(F.w_in[(size_t)k * INCOLS + NQKV + n] * F.g_attn[k]); }
    rows_to_bf16(F, F.x, F.bufA, F.rinv);
}
__device__ __forceinline__ void wd_convert(Frame& F, int first_wg) {
    const int tid = pg8::fresh_tid(F.wave), lane = tid & 63, wave = __builtin_amdgcn_readfirstlane(tid >> 6);
    LAS float* scr = (LAS float*)(F.lds + RING_OFF + wave * 16384);
    const int nw = (F.G - first_wg) * NWAVES, w0 = ((int)blockIdx.x - first_wg) * NWAVES + wave;
    constexpr int I_D = (DFF / 64) * (DM / 32);
    for (int r = w0; r < I_D; r += nw) { const int nblk = DM / 32, kb = r / nblk, nb = r % nblk; transpose_item<false>(F.w_down, DM, 64 * kb, 32 * nb, F.Wd_t, DFF, 32 * nb, scr, lane); }
}
__device__ __forceinline__ void flogit_phase(Frame& F) {
    LAS float* part = (LAS float*)(F.lds + RING_OFF);
    LAS float* ls = (LAS float*)(F.lds + RING_OFF + 4096);
    const int tid = pg8::fresh_tid(F.wave), lane = tid & 63, wave = __builtin_amdgcn_readfirstlane(tid >> 6);
    const int g = wave & 3, kh = wave >> 2, n = lane & 15, q = lane >> 4;
    for (int c = blockIdx.x; c < M / 64; c += F.G) {
        const int r0 = 64 * c;
        const bf16* hrow = F.bufA + (size_t)(r0 + 16 * g + n) * DM + kh * 2048 + 8 * q;
        const bf16* wrow = F.WfT + (size_t)n * DM + kh * 2048 + 8 * q;
        f32x4 acc = {0.f, 0.f, 0.f, 0.f};
#pragma unroll 8
        for (int s = 0; s < 64; ++s) { const bf16x8 a = *(const GAS bf16x8*)(hrow + 32 * s); const bf16x8 b = *(const GAS bf16x8*)(wrow + 32 * s);
            acc = __builtin_amdgcn_mfma_f32_16x16x32_bf16(a, b, acc, 0, 0, 0); }
        if (kh == 1) {
#pragma unroll
            for (int e = 0; e < 4; ++e) part[(16 * g + 4 * q + e) * 16 + n] = acc[e]; }
        __syncthreads();
        if (kh == 0) { const float bf = F.b_f[n];
#pragma unroll
            for (int e = 0; e < 4; ++e) { const float v = (acc[e] + part[(16 * g + 4 * q + e) * 16 + n]) * F.rinv[r0 + 16 * g + 4 * q + e] + bf;
                ls[(16 * g + 4 * q + e) * 16 + n] = fminf(v, 0.f) - log1pf(expf(-fabsf(v))); } }
        __syncthreads();
        if (wave == 0) {
            float v[16]; float run = 0.f;
#pragma unroll
            for (int j = 0; j < 16; ++j) { run += ls[(16 * q + j) * 16 + n]; v[j] = run; }
            const float t0 = __shfl(run, n), t1 = __shfl(run, n + 16), t2 = __shfl(run, n + 32);
            const float off = (q > 0 ? t0 : 0.f) + (q > 1 ? t1 : 0.f) + (q > 2 ? t2 : 0.f);
            const int b = r0 / SEQ, s0 = r0 % SEQ;
            float* dst = F.cumloc + (size_t)(b * NFH + n) * SEQ + s0 + 16 * q;
#pragma unroll
            for (int j = 0; j < 16; j += 4) *(GAS f32x4*)(dst + j) = (f32x4){v[j] + off, v[j + 1] + off, v[j + 2] + off, v[j + 3] + off};
            if (q == 3) F.ctot[(b * NFH + n) * 64 + (s0 >> 6)] = run + off;
        }
        __syncthreads();
    }
}
constexpr int D2_ITEMS = 32 * 16;
__device__ __forceinline__ att::Ref2 diff_ref(int L, int blk) {
    const int rr = L >> 8, w = L & 255, sigma = rr * 16 + (w & 7) * 2 + (w >> 7), pair = (w >> 3) & 15;
    const int qb = (blk >> 1) ? 31 - pair : pair, m = blk & 1;
    const int b = sigma >> 3, h = sigma & 7;
    att::Ref2 r; r.b = b; r.P0 = qb * 128; r.qcol = h * 2 + m; r.kcol = 16 + h * 2 + m; r.vcol = 32 + h * 2; r.head = h; r.m = m;
    return r;
}
constexpr int FOX_ITEMS = 64 * 8;
__device__ __forceinline__ att::BlockRef fox_ref(int L, int pass) {
    const int rr = L >> 8, w = L & 255, sigma = rr * 32 + (w & 7) * 4 + (w >> 6), pair = (w >> 3) & 7;
    const int qb = pass ? 15 - pair : pair;
    const int b = sigma >> 4, h = sigma & 15;
    att::BlockRef r; r.b = b; r.P0 = qb * 256; r.qcol = 48 + h; r.kcol = 64 + h; r.vcol = 80 + h; r.ocol = 2048 + h * 128; r.kind = 1; r.head = h;
    return r;
}
template <int ROLE> __device__ __forceinline__ void fox_run(Frame& F, char* lds) {
    int L = blockIdx.x;
    const int tid = pg8::fresh_tid(F.wave);
    const att::AttnBases AB{__builtin_amdgcn_make_buffer_rsrc((void*)F.bufB, 0, (int)((size_t)M * NQKV * 2), 0x00020000), F.od, F.mx, F.cumloc, F.ctot, F.relt, F.subg, 0.f};
    const int stride = F.G;
    int pass = 0;
    att::BlockRef cur = fox_ref(L, 0);
    att::Seam S;
    att::attn_prime(AB, cur, F.lds + RING_OFF, S, tid);
    for (;;) {
        const bool more_pass = pass == 0, more_item = L + stride < FOX_ITEMS, last = !more_pass && !more_item;
        int passn = pass + 1, Ln = L;
        if (!more_pass) { passn = 0; Ln = more_item ? L + stride : L; }
        const att::BlockRef nxt = last ? cur : fox_ref(Ln, passn);
        if (pass == 0) att::attn_tables(AB, fox_ref(L, 1), F.lds + RING_OFF, tid);
        att::attn_block<1, ROLE>(AB, cur, nxt, lds, F.lds + RING_OFF, S, tid);
        if (last) break;
        cur = nxt; pass = passn; L = Ln;
    }
}
__device__ __forceinline__ void fox_phase(Frame& F, char* lds) {
    if ((int)blockIdx.x >= FOX_ITEMS) return;
    if (F.wave < 4) fox_run<0>(F, lds); else fox_run<1>(F, lds);
}
__device__ __forceinline__ void diff_phase(Frame& F, char* lds) {
    const int tid = pg8::fresh_tid(F.wave);
    float lam;
    {   const int l = tid & 63;
        const float s1 = wave_sum(F.lq1[l] * F.lk1[l] + F.lq1[l + 64] * F.lk1[l + 64]), s2 = wave_sum(F.lq2[l] * F.lk2[l] + F.lq2[l + 64] * F.lk2[l + 64]);
        lam = __builtin_bit_cast(float, __builtin_amdgcn_readfirstlane(__builtin_bit_cast(int, expf(s1) - expf(s2) + 0.2f))); }
    const att::AttnBases AB{__builtin_amdgcn_make_buffer_rsrc((void*)F.bufB, 0, (int)((size_t)M * NQKV * 2), 0x00020000), F.od, F.mx, F.cumloc, F.ctot, F.relt, F.subg, lam};
    for (int L = blockIdx.x; L < D2_ITEMS; L += F.G) {
#pragma unroll 1
        for (int blk = 0; blk < 4; ++blk) att::diff_block(AB, diff_ref(L, blk), lds, F.lds + RING_OFF, tid);
    }
}
struct Args { const float* in[16]; float* out; unsigned char* ws; };
__global__ void __launch_bounds__(NWAVES * 64, 2) hybrid_fwd(Args args) {
    extern __shared__ __attribute__((aligned(16))) unsigned char lds[];
    Frame F;
    F.lds = (LAS unsigned char*)lds;
    F.MISC = (volatile LAS unsigned*)(F.lds + MISC_OFF);
    F.tid = threadIdx.x; F.lane = F.tid & 63; F.wave = __builtin_amdgcn_readfirstlane(F.tid >> 6);
    F.G = gridDim.x; { const int bx = blockIdx.x; F.vcu = (F.G % 8 == 0) ? (bx % 8) * (F.G / 8) + bx / 8 : bx; }
    unsigned char* ws = args.ws;
    F.ctl = (gu32*)(ws + WS_CTL);
    F.x = args.in[0]; F.g_attn = args.in[1]; F.w_in = args.in[2]; F.b_f = args.in[3]; F.lq1 = args.in[4]; F.lk1 = args.in[5]; F.lq2 = args.in[6]; F.lk2 = args.in[7];
    F.relt = args.in[8]; F.subg = args.in[9]; F.w_o = args.in[10]; F.g_ffn = args.in[11]; F.w_gate = args.in[12]; F.w_up = args.in[13]; F.w_down = args.in[14]; F.g_final = args.in[15];
    F.out = args.out;
    F.Win_t = (bf16*)(ws + WS_WIN); F.WfT = (bf16*)(ws + WS_WFT); F.Wo_t = (bf16*)(ws + WS_WO); F.Wgu_t = (bf16*)(ws + WS_WGU); F.Wd_t = (bf16*)(ws + WS_WD);
    F.bufA = (bf16*)(ws + WS_A); F.bufB = (bf16*)(ws + WS_B); F.od = (bf16*)args.out; F.xb = (bf16*)(ws + WS_XB);
    F.cumloc = (float*)(ws + WS_CUMLOC); F.ctot = (float*)(ws + WS_CTOT);
    F.mx = F.od + (size_t)M * DM; F.rinv = (float*)(F.ctl + CW_ROWSS + M);
    for (int u = F.tid; u < (LDS_BYTES - LDSCTL_OFF) / 4; u += NWAVES * 64) ((LAS unsigned*)(F.lds + LDSCTL_OFF))[u] = 0u;
    __syncthreads();
    XcdBarrier bar = xcd_barrier_post((unsigned*)(F.ctl + CW_BAR), F.MISC + 8);
#define GRID_BAR() xcd_barrier(bar)

    p0_prologue(F);
    GRID_BAR();
    flogit_phase(F);
    {   pg8::Gemm g{F.bufA, F.Win_t, M, NQKV, DM}; pg8::StaticOrder S; S.init(M, NQKV, F.G, (int)blockIdx.x);
        pg8::EpiQKVSlab E{F.bufB, SEQ, F.rinv};
        pg8::gemm_phase<pg8::EpiQKVSlab, pg8::StaticOrder, true, true>(F.lds + RING_OFF, g, S, E, F.wave); }
    GRID_BAR();
    fox_phase(F, (char*)lds + RING_OFF);
    __syncthreads();
    diff_phase(F, (char*)lds + RING_OFF);
    GRID_BAR();
    {   pg8::Gemm g{F.mx, F.Wo_t, M, DM, DM}; pg8::StaticOrder S; S.init(M, DM, F.G, (int)blockIdx.x);
        pg8::EpiResBToBf16Stats E{F.bufA, F.xb, DM, (float*)(F.ctl + CW_ROWSS)};
        pg8::gemm_phase<pg8::EpiResBToBf16Stats, pg8::StaticOrder, true, true>(F.lds + RING_OFF, g, S, E, F.wave); }
    GRID_BAR();
    {   pg8::Gemm g{F.xb, F.Wgu_t, M, NGU, DM}; pg8::StaticOrder S; S.init(M, NGU, F.G, (int)blockIdx.x);
        pg8::EpiSwiGLU E{F.bufB, DFF, (const float*)(F.ctl + CW_ROWSS), 1.0f / DM, EPS};
        pg8::gemm_phase<pg8::EpiSwiGLU, pg8::StaticOrder, true, true>(F.lds + RING_OFF, g, S, E, F.wave);
        const int rem = ((M / 256) * (NGU / 256)) % F.G;
        if ((int)blockIdx.x >= rem) wd_convert(F, rem); }
    GRID_BAR();
    {   pg8::Gemm g{F.bufB, F.Wd_t, M, DM, DFF}; pg8::StaticOrder S; S.init(M, DM, F.G, (int)blockIdx.x);
        pg8::EpiResBf16 E{F.xb, F.bufA, DM};
        pg8::gemm_phase<pg8::EpiResBf16, pg8::StaticOrder, true, true>(F.lds + RING_OFF, g, S, E, F.wave); }
    GRID_BAR();
    {   const bool bad = __hip_atomic_load(F.ctl + CW_BAR + XB_TMO, RLX_AGENT) != 0u || __hip_atomic_load(F.ctl + CW_TMO, RLX_AGENT) != 0u;
        norm_rows_bf16in(F, F.bufA, F.g_final, F.out, bad); }
#undef GRID_BAR
}

extern "C" void kernel_launch(void* const* d_in, const int* in_sizes, int n_in, void* d_out, int out_size, void* d_ws, size_t ws_size, hipStream_t stream) {
    static int grid = 0;
    if (grid == 0) {
        if (n_in != 16 || in_sizes[0] != M * DM || out_size != M * DM || ws_size < WS_END) { fprintf(stderr, "kernel_launch: shape/workspace mismatch (n_in %d, in0 %d, out %d, ws %zu); nothing launched\n", n_in, n_in > 0 ? in_sizes[0] : -1, out_size, ws_size); grid = -1; return; }
        int dev = 0, cus = 0, per_cu = 0;
        if (hipGetDevice(&dev) != hipSuccess || hipDeviceGetAttribute(&cus, hipDeviceAttributeMultiprocessorCount, dev) != hipSuccess) { fprintf(stderr, "kernel_launch: device query failed\n"); grid = -1; return; }
        if (hipFuncSetAttribute((const void*)hybrid_fwd, hipFuncAttributeMaxDynamicSharedMemorySize, LDS_BYTES) != hipSuccess) { fprintf(stderr, "kernel_launch: hipFuncSetAttribute failed\n"); grid = -1; return; }
        if (hipOccupancyMaxActiveBlocksPerMultiprocessor(&per_cu, (const void*)hybrid_fwd, NWAVES * 64, LDS_BYTES) != hipSuccess || per_cu < 1)
            fprintf(stderr, "kernel_launch: note: occupancy query reports %d workgroups per CU\n", per_cu);
        (void)hipGetLastError();
        grid = cus;
    }
    if (grid < 0) return;
    if (hipMemsetAsync((char*)d_ws + WS_CTL, 0, CTL_ZERO_BYTES, stream) != hipSuccess) { fprintf(stderr, "kernel_launch: hipMemsetAsync failed\n"); return; }
    Args a{};
    for (int i = 0; i < 16; ++i) a.in[i] = (const float*)d_in[i];
    a.out = (float*)d_out; a.ws = (unsigned char*)d_ws;
    hipLaunchKernelGGL(hybrid_fwd, dim3(grid), dim3(NWAVES * 64), LDS_BYTES, stream, a);
    const hipError_t le = hipPeekAtLastError();
    if (le != hipSuccess) fprintf(stderr, "kernel_launch: launch failed: %s\n", hipGetErrorName(le));
}
```

```cpp
#include <hip/hip_runtime.h>
#include <cstdio>
#include <cstdint>
#include <cmath>
namespace pg8 {
#define PG8_LAS __attribute__((address_space(3)))
typedef unsigned short bf16_t;
typedef short bf16x8 __attribute__((ext_vector_type(8)));
typedef float f32x4 __attribute__((ext_vector_type(4)));
typedef unsigned u32x4 __attribute__((ext_vector_type(4)));
constexpr int BM = 256, BK = 64, HALF = 128, HTB = HALF * BK * 2  , STAGE_BYTES = 8 * HTB, NXCD = 8, WGM = 8;

__host__ __device__ __forceinline__ int lds_byte(int r, int c) { const int st = (r >> 4) * 2 + (c >> 5), rr = r & 15, cc = c & 31, ob = rr * 64 + cc * 2; return st * 1024 + (ob ^ (((ob >> 9) & 1) << 5)); }
__host__ __device__ __forceinline__ void stage_rc(int b, int& R, int& C) { const int st = b / 1024, sb = b % 1024, swz = sb ^ (((sb >> 9) & 1) << 5); R = (st >> 1) * 16 + swz / 64; C = (st & 1) * 32 + (swz % 64) / 2; }
__host__ __device__ __forceinline__ int perm32(int rho) { const int n = rho >> 4, i = rho & 15; return 8 * (i >> 2) + 4 * n + (i & 3); }

struct Unit { int pm, pn; };
struct Gemm { const bf16_t* A; const bf16_t* Bt; int M, N, K; };

struct StaticOrder {
    int nM, nN, nwg, G, c;
    __host__ __device__ void init(int M, int N, int G_, int c_) { nM = M / BM; nN = N / BM; nwg = nM * nN; G = G_; c = c_; }
    __host__ __device__ bool next(int i, Unit& u) const {
        const long L = (long)i * G + c; if (L >= nwg) return false;
        int wgid = (int)L; { const int q = nwg / NXCD, r = nwg % NXCD, xcd = wgid % NXCD, off = wgid / NXCD; wgid = (xcd < r ? xcd * (q + 1) : r * (q + 1) + (xcd - r) * q) + off; }
        const int nig = WGM * nN, gid = wgid / nig, fm = gid * WGM, gsz = (nM - fm) < WGM ? (nM - fm) : WGM;
        u.pm = fm + ((wgid % nig) % gsz); u.pn = (wgid % nig) / gsz; return true;
    }
    __device__ __forceinline__ void a_ready(const Unit&) const {}
    __device__ __forceinline__ void done(const Unit&) const {}
};

__device__ __forceinline__ unsigned cvt_pk_bf16(float lo, float hi) { unsigned r; asm volatile("v_cvt_pk_bf16_f32 %0, %1, %2" : "=v"(r) : "v"(lo), "v"(hi)); return r; }
typedef float f32x2 __attribute__((ext_vector_type(2)));
__device__ __forceinline__ int fresh_lane() { int l; asm volatile("v_mbcnt_lo_u32_b32 %0, -1, 0\n\tv_mbcnt_hi_u32_b32 %0, -1, %0" : "=v"(l)); return l; }
__device__ __forceinline__ int fresh_tid(int wave) { return wave * 64 + fresh_lane(); }
struct EpiBf16Plain {
    static constexpr bool PERM = true, AFTER_DRAIN = false;
    bf16_t* O; int ldc;
    __device__ __forceinline__ void operator()(const f32x4 (&acc)[2][2][4][2], const Unit& u, int wr, int wc, int fr, int fq) const {
        const int row0 = u.pm * BM + wr * 64 + fr, col0 = u.pn * BM + wc * 32 + 8 * fq;
#pragma unroll
        for (int ai = 0; ai < 2; ++ai)
#pragma unroll
            for (int m = 0; m < 4; ++m) { bf16_t* rowp = O + (size_t)(row0 + ai * HALF + m * 16) * ldc + col0;
#pragma unroll
                for (int bj = 0; bj < 2; ++bj) { const f32x4 v0 = acc[ai][bj][m][0], v1 = acc[ai][bj][m][1];
                    u32x4 w; w.x = cvt_pk_bf16(v0[0], v0[1]); w.y = cvt_pk_bf16(v0[2], v0[3]); w.z = cvt_pk_bf16(v1[0], v1[1]); w.w = cvt_pk_bf16(v1[2], v1[3]);
                    *(u32x4*)(rowp + bj * HALF) = w; } }
    }
};
__device__ __forceinline__ float silu_mul(float g, float u) { return g * __builtin_amdgcn_rcpf(1.0f + __builtin_amdgcn_exp2f(g * -1.4426950408889634f)) * u; }
struct EpiSwiGLU {
    static constexpr bool PERM = true, AFTER_DRAIN = false;
    bf16_t* O; int ldc; const float* rowss; float inv_k, eps;
    __device__ __forceinline__ void operator()(const f32x4 (&acc)[2][2][4][2], const Unit& u, int wr, int wc, int fr, int fq) const {
        const int row0 = u.pm * BM + wr * 64 + fr, col0 = u.pn * HALF + wc * 32 + 8 * fq;
#pragma unroll
        for (int ai = 0; ai < 2; ++ai)
#pragma unroll
            for (int m = 0; m < 4; ++m) { const int row = row0 + ai * HALF + m * 16; bf16_t* rowp = O + (size_t)row * ldc + col0;
                const float rr = __builtin_amdgcn_rsqf(rowss[row] * inv_k + eps);
                const f32x4 g0 = acc[ai][0][m][0] * rr, g1 = acc[ai][0][m][1] * rr, u0 = acc[ai][1][m][0] * rr, u1 = acc[ai][1][m][1] * rr;
                u32x4 w; w.x = cvt_pk_bf16(silu_mul(g0[0], u0[0]), silu_mul(g0[1], u0[1])); w.y = cvt_pk_bf16(silu_mul(g0[2], u0[2]), silu_mul(g0[3], u0[3]));
                w.z = cvt_pk_bf16(silu_mul(g1[0], u1[0]), silu_mul(g1[1], u1[1])); w.w = cvt_pk_bf16(silu_mul(g1[2], u1[2]), silu_mul(g1[3], u1[3]));
                *(u32x4*)rowp = w; }
    }
};
template <bool STATS> struct EpiResF32 {
    static constexpr bool PERM = true, AFTER_DRAIN = false;
    const float* res; float* out; int ldc; bf16_t* xb; float* rowss;
    __device__ __forceinline__ void operator()(const f32x4 (&acc)[2][2][4][2], const Unit& u, int wr, int wc, int fr, int fq) const {
        const int row0 = u.pm * BM + wr * 64 + fr, col0 = u.pn * BM + wc * 32 + 8 * fq;
#pragma unroll
        for (int ai = 0; ai < 2; ++ai)
#pragma unroll
            for (int m = 0; m < 4; ++m) { const int row = row0 + ai * HALF + m * 16; const size_t off = (size_t)row * ldc + col0;
                f32x4 r[2][2];
#pragma unroll
                for (int bj = 0; bj < 2; ++bj)
#pragma unroll
                    for (int n = 0; n < 2; ++n) r[bj][n] = *(const f32x4*)(res + off + bj * HALF + n * 4);
                float ss = 0.f;
#pragma unroll
                for (int bj = 0; bj < 2; ++bj) {
#pragma unroll
                    for (int n = 0; n < 2; ++n) { r[bj][n] = r[bj][n] + acc[ai][bj][m][n]; *(f32x4*)(out + off + bj * HALF + n * 4) = r[bj][n];
                        if (STATS) ss += (r[bj][n][0] * r[bj][n][0] + r[bj][n][1] * r[bj][n][1]) + (r[bj][n][2] * r[bj][n][2] + r[bj][n][3] * r[bj][n][3]); }
                    if (STATS) { u32x4 w; w.x = cvt_pk_bf16(r[bj][0][0], r[bj][0][1]); w.y = cvt_pk_bf16(r[bj][0][2], r[bj][0][3]); w.z = cvt_pk_bf16(r[bj][1][0], r[bj][1][1]); w.w = cvt_pk_bf16(r[bj][1][2], r[bj][1][3]);
                        *(u32x4*)(xb + off + bj * HALF) = w; } }
                if (STATS) { ss += __shfl_xor(ss, 16); ss += __shfl_xor(ss, 32);
                    if (fq == 0) (void)__hip_atomic_fetch_add(rowss + row, ss, __ATOMIC_RELAXED, __HIP_MEMORY_SCOPE_AGENT); } }
    }
};

struct EpiResF32Plain {
    static constexpr bool PERM = false, AFTER_DRAIN = false;
    const float* res; float* out; int ldc;
    __device__ __forceinline__ void operator()(const f32x4 (&acc)[2][2][4][2], const Unit& u, int wr, int wc, int fr, int fq) const {
        const int row0 = u.pm * BM + wr * 64 + fr, col0 = u.pn * BM + wc * 32 + 4 * fq;
#pragma unroll
        for (int ai = 0; ai < 2; ++ai)
#pragma unroll
            for (int m = 0; m < 4; ++m) { const size_t off = (size_t)(row0 + ai * HALF + m * 16) * ldc + col0;
                f32x4 r[2][2];
#pragma unroll
                for (int bj = 0; bj < 2; ++bj)
#pragma unroll
                    for (int n = 0; n < 2; ++n) r[bj][n] = *(const f32x4*)(res + off + bj * HALF + n * 16);
#pragma unroll
                for (int bj = 0; bj < 2; ++bj)
#pragma unroll
                    for (int n = 0; n < 2; ++n) *(f32x4*)(out + off + bj * HALF + n * 16) = r[bj][n] + acc[ai][bj][m][n]; }
    }
};

struct EpiResToBf16Stats {
    static constexpr bool PERM = true, AFTER_DRAIN = false;
    const float* res; bf16_t* xb; int ldc; float* rowss;
    __device__ __forceinline__ void operator()(const f32x4 (&acc)[2][2][4][2], const Unit& u, int wr, int wc, int fr, int fq) const {
        const int row0 = u.pm * BM + wr * 64 + fr, col0 = u.pn * BM + wc * 32 + 8 * fq;
        f32x4 rA[2][2][2], rB[2][2][2];
#define EPI_LOAD(dst, q) do { _Pragma("unroll") for (int h_ = 0; h_ < 2; ++h_) { const int gi_ = 2 * (q) + h_; const size_t off_ = (size_t)(row0 + (gi_ >> 2) * HALF + (gi_ & 3) * 16) * ldc + col0;          \
            _Pragma("unroll") for (int bj = 0; bj < 2; ++bj) _Pragma("unroll") for (int n = 0; n < 2; ++n) dst[h_][bj][n] = *(const f32x4*)(res + off_ + bj * HALF + n * 4); } } while (0)
#define EPI_DONE(src, q) do { _Pragma("unroll") for (int h_ = 0; h_ < 2; ++h_) { const int gi_ = 2 * (q) + h_, ai = gi_ >> 2, m = gi_ & 3; const int row = row0 + ai * HALF + m * 16; const size_t off = (size_t)row * ldc + col0;   \
            float ss = 0.f;                                                                                                                                                              \
            _Pragma("unroll") for (int bj = 0; bj < 2; ++bj) { f32x4 v0 = src[h_][bj][0] + acc[ai][bj][m][0], v1 = src[h_][bj][1] + acc[ai][bj][m][1];                                     \
                ss += (v0[0] * v0[0] + v0[1] * v0[1]) + (v0[2] * v0[2] + v0[3] * v0[3]) + (v1[0] * v1[0] + v1[1] * v1[1]) + (v1[2] * v1[2] + v1[3] * v1[3]);                               \
                u32x4 w; w.x = cvt_pk_bf16(v0[0], v0[1]); w.y = cvt_pk_bf16(v0[2], v0[3]); w.z = cvt_pk_bf16(v1[0], v1[1]); w.w = cvt_pk_bf16(v1[2], v1[3]);                               \
                *(u32x4*)(xb + off + bj * HALF) = w; }                                                                                                                                     \
            ss += __shfl_xor(ss, 16); ss += __shfl_xor(ss, 32);                                                                                                                            \
            if (fq == 0) (void)__hip_atomic_fetch_add(rowss + row, ss, __ATOMIC_RELAXED, __HIP_MEMORY_SCOPE_AGENT); } } while (0)
        EPI_LOAD(rA, 0); EPI_LOAD(rB, 1);
        EPI_DONE(rA, 0); EPI_LOAD(rA, 2);
        EPI_DONE(rB, 1); EPI_LOAD(rB, 3);
        EPI_DONE(rA, 2);
        EPI_DONE(rB, 3);
#undef EPI_LOAD
#undef EPI_DONE
    }
};
struct EpiResBToBf16Stats {
    static constexpr bool PERM = true, AFTER_DRAIN = false;
    const bf16_t* resb; bf16_t* xb; int ldc; float* rowss;
    __device__ __forceinline__ void operator()(const f32x4 (&acc)[2][2][4][2], const Unit& u, int wr, int wc, int fr, int fq) const {
        const int row0 = u.pm * BM + wr * 64 + fr, col0 = u.pn * BM + wc * 32 + 8 * fq;
        u32x4 rA[2][2], rB[2][2];
#define EPI_LOAD(dst, q) do { _Pragma("unroll") for (int h_ = 0; h_ < 2; ++h_) { const int gi_ = 2 * (q) + h_; const size_t off_ = (size_t)(row0 + (gi_ >> 2) * HALF + (gi_ & 3) * 16) * ldc + col0;          \
            _Pragma("unroll") for (int bj = 0; bj < 2; ++bj) dst[h_][bj] = *(const u32x4*)(resb + off_ + bj * HALF); } } while (0)
#define EPI_DONE(src, q) do { _Pragma("unroll") for (int h_ = 0; h_ < 2; ++h_) { const int gi_ = 2 * (q) + h_, ai = gi_ >> 2, m = gi_ & 3; const int row = row0 + ai * HALF + m * 16; const size_t off = (size_t)row * ldc + col0;   \
            float ss = 0.f;                                                                                                                                                              \
            _Pragma("unroll") for (int bj = 0; bj < 2; ++bj) { const u32x4 hb = src[h_][bj];                                                                                              \
                const f32x4 x0 = {__uint_as_float(hb.x << 16), __uint_as_float(hb.x & 0xffff0000u), __uint_as_float(hb.y << 16), __uint_as_float(hb.y & 0xffff0000u)};                    \
                const f32x4 x1 = {__uint_as_float(hb.z << 16), __uint_as_float(hb.z & 0xffff0000u), __uint_as_float(hb.w << 16), __uint_as_float(hb.w & 0xffff0000u)};                    \
                const f32x4 v0 = x0 + acc[ai][bj][m][0], v1 = x1 + acc[ai][bj][m][1];                                                                                                     \
                ss += (v0[0] * v0[0] + v0[1] * v0[1]) + (v0[2] * v0[2] + v0[3] * v0[3]) + (v1[0] * v1[0] + v1[1] * v1[1]) + (v1[2] * v1[2] + v1[3] * v1[3]);                               \
                u32x4 w; w.x = cvt_pk_bf16(v0[0], v0[1]); w.y = cvt_pk_bf16(v0[2], v0[3]); w.z = cvt_pk_bf16(v1[0], v1[1]); w.w = cvt_pk_bf16(v1[2], v1[3]);                               \
                *(u32x4*)(xb + off + bj * HALF) = w; }                                                                                                                                     \
            ss += __shfl_xor(ss, 16); ss += __shfl_xor(ss, 32);                                                                                                                            \
            if (fq == 0) (void)__hip_atomic_fetch_add(rowss + row, ss, __ATOMIC_RELAXED, __HIP_MEMORY_SCOPE_AGENT); } } while (0)
        EPI_LOAD(rA, 0); EPI_LOAD(rB, 1);
        EPI_DONE(rA, 0); EPI_LOAD(rA, 2);
        EPI_DONE(rB, 1); EPI_LOAD(rB, 3);
        EPI_DONE(rA, 2);
        EPI_DONE(rB, 3);
#undef EPI_LOAD
#undef EPI_DONE
    }
};
struct EpiResBf16 {
    static constexpr bool PERM = true, AFTER_DRAIN = false;
    const bf16_t* res; bf16_t* out; int ldc;
    __device__ __forceinline__ void operator()(const f32x4 (&acc)[2][2][4][2], const Unit& u, int wr, int wc, int fr, int fq) const {
        const int row0 = u.pm * BM + wr * 64 + fr, col0 = u.pn * BM + wc * 32 + 8 * fq;
        u32x4 rb[2][4][2];
#pragma unroll
        for (int ai = 0; ai < 2; ++ai)
#pragma unroll
            for (int m = 0; m < 4; ++m)
#pragma unroll
                for (int bj = 0; bj < 2; ++bj) rb[ai][m][bj] = *(const u32x4*)(res + (size_t)(row0 + ai * HALF + m * 16) * ldc + col0 + bj * HALF);
#pragma unroll
        for (int ai = 0; ai < 2; ++ai)
#pragma unroll
            for (int m = 0; m < 4; ++m) { const size_t off = (size_t)(row0 + ai * HALF + m * 16) * ldc + col0;
#pragma unroll
                for (int bj = 0; bj < 2; ++bj) { const f32x4 a0 = acc[ai][bj][m][0], a1 = acc[ai][bj][m][1]; const u32x4 r = rb[ai][m][bj]; u32x4 w;
                    w.x = cvt_pk_bf16(__uint_as_float(r.x << 16) + a0[0], __uint_as_float(r.x & 0xffff0000u) + a0[1]);
                    w.y = cvt_pk_bf16(__uint_as_float(r.y << 16) + a0[2], __uint_as_float(r.y & 0xffff0000u) + a0[3]);
                    w.z = cvt_pk_bf16(__uint_as_float(r.z << 16) + a1[0], __uint_as_float(r.z & 0xffff0000u) + a1[1]);
                    w.w = cvt_pk_bf16(__uint_as_float(r.w << 16) + a1[2], __uint_as_float(r.w & 0xffff0000u) + a1[3]);
                    *(u32x4*)(out + off + bj * HALF) = w; } }
    }
};
struct EpiQKVSlab {
    static constexpr bool PERM = true, AFTER_DRAIN = false;
    bf16_t* O; int seq; const float* rinv;
    __device__ __forceinline__ void operator()(const f32x4 (&acc)[2][2][4][2], const Unit& u, int wr, int wc, int fr, int fq) const {
        const int row0 = u.pm * BM + wr * 64 + fr, b = row0 / seq, s0 = row0 - b * seq;
        float rs[2][4];
#pragma unroll
        for (int ai = 0; ai < 2; ++ai)
#pragma unroll
            for (int m = 0; m < 4; ++m) rs[ai][m] = rinv[row0 + ai * HALF + m * 16];
#pragma unroll
        for (int bj = 0; bj < 2; ++bj) { bf16_t* slab = O + ((size_t)(b * 96 + u.pn * 2 + bj) * seq + s0) * 128 + wc * 32 + 8 * fq;
#pragma unroll
            for (int ai = 0; ai < 2; ++ai)
#pragma unroll
                for (int m = 0; m < 4; ++m) { const f32x4 v0 = acc[ai][bj][m][0] * rs[ai][m], v1 = acc[ai][bj][m][1] * rs[ai][m];
                    u32x4 w; w.x = cvt_pk_bf16(v0[0], v0[1]); w.y = cvt_pk_bf16(v0[2], v0[3]); w.z = cvt_pk_bf16(v1[0], v1[1]); w.w = cvt_pk_bf16(v1[2], v1[3]);
                    *(u32x4*)(slab + (size_t)(ai * HALF + m * 16) * 128) = w; } }
    }
};
template <class Epi, class Sched, bool ALIGN_EPI = false, bool SP2 = false>
__device__ __forceinline__ void gemm_phase(PG8_LAS unsigned char* lds, const Gemm g, const Sched& S, const Epi& E, const int wave) {
    const int tid = fresh_tid(wave), wid = __builtin_amdgcn_readfirstlane(tid >> 6), lane = tid & 63, wr = wid >> 2, wc = wid & 3, fr = lane & 15, fq = lane >> 4;
    const int K = g.K, nt = K / BK;
    unsigned voffA[2], voffB[2];
#pragma unroll
    for (int i = 0; i < 2; ++i) { int R, C; stage_rc(tid * 16 + i * 8192, R, C); const int Rb = Epi::PERM ? ((R & ~31) + perm32(R & 31)) : R;
        voffA[i] = (unsigned)(R * K + C) * 2u; voffB[i] = (unsigned)(Rb * K + C) * 2u; }
    const size_t kstep = (size_t)(BK * 2);
    const size_t hstep = (size_t)HALF * K * 2;
    const size_t tstep = 2 * hstep;
    const unsigned ldsw = (unsigned)wid * 1024u;
    const int aoff = lds_byte(wr * 64 + fr, fq * 8), boff = lds_byte(wc * 32 + fr, fq * 8);
#define PG8_SA(b, h) (((b) * 2 + (h)) * HTB)
#define PG8_SB(b, h) ((4 + (b) * 2 + (h)) * HTB)
#define PG8_STAGE(bufoff, gbase, voff) do { _Pragma("unroll") for (int _i = 0; _i < 2; ++_i) \
        __builtin_amdgcn_global_load_lds((const unsigned*)((const char*)(gbase) + (voff)[_i]), (PG8_LAS unsigned*)(lds + (bufoff) + ldsw + _i * 8192), 16, 0, 0); } while (0)
#define PG8_LDA(dst, b, h) do { _Pragma("unroll") for (int m = 0; m < 4; ++m) _Pragma("unroll") for (int k = 0; k < 2; ++k) dst[m][k] = *(const PG8_LAS bf16x8*)(lds + PG8_SA(b, h) + aoff + m * 2048 + k * 1024); } while (0)
#define PG8_LDB(dst, b, h) do { _Pragma("unroll") for (int n = 0; n < 2; ++n) _Pragma("unroll") for (int k = 0; k < 2; ++k) dst[n][k] = *(const PG8_LAS bf16x8*)(lds + PG8_SB(b, h) + boff + n * 2048 + k * 1024); } while (0)
#define PG8_MMA(ai, bj, At, Bt) do { __builtin_amdgcn_s_setprio(1); _Pragma("unroll") for (int m = 0; m < 4; ++m) _Pragma("unroll") for (int n = 0; n < 2; ++n) _Pragma("unroll") for (int k = 0; k < 2; ++k) \
        acc[ai][bj][m][n] = __builtin_amdgcn_mfma_f32_16x16x32_bf16(Bt[n][k], At[m][k], acc[ai][bj][m][n], 0, 0, 0); __builtin_amdgcn_s_setprio(0); } while (0)
#define PG8_WAIT_V(n) asm volatile("s_waitcnt vmcnt(" #n ")" ::: "memory")
#define PG8_WAIT_L(n) asm volatile("s_waitcnt lgkmcnt(" #n ")" ::: "memory")
#define PG8_BAR __builtin_amdgcn_s_barrier()
#define PG8_SCHED __builtin_amdgcn_sched_barrier(0)
    Unit cur, nxt; int ui = 0;
    if (!S.next(0, cur)) return;
    f32x4 acc[2][2][4][2];
#pragma unroll
    for (int a = 0; a < 2; ++a)
#pragma unroll
        for (int b = 0; b < 2; ++b)
#pragma unroll
            for (int m = 0; m < 4; ++m)
#pragma unroll
                for (int n = 0; n < 2; ++n) acc[a][b][m][n] = (f32x4){0.f, 0.f, 0.f, 0.f};
    bf16x8 At[4][2], B0[2][2], B1[2][2];
    const char* cA = (const char*)g.A + (size_t)cur.pm * tstep; const char* cB = (const char*)g.Bt + (size_t)cur.pn * tstep;
    S.a_ready(cur);
    if constexpr (SP2) {
        PG8_STAGE(PG8_SB(0, 0), cB, voffB); PG8_STAGE(PG8_SB(0, 1), cB + hstep, voffB); PG8_STAGE(PG8_SA(0, 0), cA, voffA); PG8_STAGE(PG8_SA(0, 1), cA + hstep, voffA);
        if (wr == 1) PG8_BAR;
        PG8_WAIT_V(2); PG8_BAR;
        PG8_STAGE(PG8_SB(1, 0), cB + kstep, voffB); PG8_STAGE(PG8_SA(1, 0), cA + kstep, voffA); PG8_STAGE(PG8_SB(1, 1), cB + hstep + kstep, voffB);
        PG8_WAIT_V(6); PG8_BAR;
    } else {
        PG8_STAGE(PG8_SB(0, 0), cB, voffB); PG8_STAGE(PG8_SA(0, 0), cA, voffA); PG8_STAGE(PG8_SB(0, 1), cB + hstep, voffB); PG8_STAGE(PG8_SA(0, 1), cA + hstep, voffA);
        if (wr == 1) PG8_BAR;
        PG8_WAIT_V(4); PG8_BAR;
        PG8_STAGE(PG8_SB(1, 0), cB + kstep, voffB); PG8_STAGE(PG8_SA(1, 0), cA + kstep, voffA); PG8_STAGE(PG8_SB(1, 1), cB + hstep + kstep, voffB);
        PG8_WAIT_V(6); PG8_BAR;
    }
    for (;;) {
        const bool has_next = S.next(ui + 1, nxt);
        const char* nA = has_next ? (const char*)g.A + (size_t)nxt.pm * tstep : cA; const char* nB = has_next ? (const char*)g.Bt + (size_t)nxt.pn * tstep : cB;
        for (int t = 0; t < nt; t += 2) {
            const bool last = (t == nt - 2);
            const char* a1 = cA + (size_t)(t + 1) * kstep;
            const char* a2 = last ? nA : cA + (size_t)(t + 2) * kstep; const char* b2 = last ? nB : cB + (size_t)(t + 2) * kstep;
            const char* a3 = a2 + kstep; const char* b3 = b2 + kstep;
            if (last && has_next) S.a_ready(nxt);
            if constexpr (SP2) {
            PG8_LDB(B0, 0, 0); PG8_LDB(B1, 0, 1); PG8_SCHED; PG8_LDA(At, 0, 0); PG8_STAGE(PG8_SA(1, 1), a1 + hstep, voffA);
            PG8_WAIT_V(8); PG8_WAIT_L(0); PG8_BAR; PG8_MMA(0, 0, At, B0); PG8_MMA(0, 1, At, B1); PG8_BAR; PG8_SCHED;
            PG8_LDA(At, 0, 1); PG8_STAGE(PG8_SB(0, 0), b2, voffB); PG8_STAGE(PG8_SB(0, 1), b2 + hstep, voffB); PG8_STAGE(PG8_SA(0, 0), a2, voffA);
            PG8_WAIT_V(8); PG8_WAIT_L(0); PG8_BAR; PG8_MMA(1, 0, At, B0); PG8_MMA(1, 1, At, B1); PG8_BAR; PG8_SCHED;
            PG8_LDB(B0, 1, 0); PG8_LDB(B1, 1, 1); PG8_SCHED; PG8_LDA(At, 1, 0); PG8_STAGE(PG8_SA(0, 1), a2 + hstep, voffA);
            PG8_WAIT_V(8); PG8_WAIT_L(0); PG8_BAR; PG8_MMA(0, 0, At, B0); PG8_MMA(0, 1, At, B1); PG8_BAR; PG8_SCHED;
            PG8_LDA(At, 1, 1); PG8_STAGE(PG8_SB(1, 0), b3, voffB); PG8_STAGE(PG8_SB(1, 1), b3 + hstep, voffB); PG8_STAGE(PG8_SA(1, 0), a3, voffA);
            PG8_WAIT_V(8); PG8_WAIT_L(0); PG8_BAR; PG8_MMA(1, 0, At, B0); PG8_MMA(1, 1, At, B1); PG8_BAR; PG8_SCHED;
            } else {
            PG8_LDB(B0, 0, 0); PG8_SCHED; PG8_LDA(At, 0, 0); PG8_STAGE(PG8_SA(1, 1), a1 + hstep, voffA);
            PG8_WAIT_L(8); PG8_BAR; PG8_WAIT_L(0); PG8_MMA(0, 0, At, B0); PG8_BAR; PG8_SCHED;
            PG8_LDB(B1, 0, 1); PG8_STAGE(PG8_SB(0, 0), b2, voffB);
            PG8_BAR; PG8_WAIT_L(0); PG8_MMA(0, 1, At, B1); PG8_BAR;
            PG8_LDA(At, 0, 1); PG8_STAGE(PG8_SA(0, 0), a2, voffA);
            PG8_BAR; PG8_WAIT_L(0); PG8_MMA(1, 0, At, B0); PG8_BAR; PG8_SCHED;
            PG8_STAGE(PG8_SB(0, 1), b2 + hstep, voffB);
            PG8_WAIT_V(6); PG8_BAR; PG8_MMA(1, 1, At, B1); PG8_BAR;
            PG8_LDB(B0, 1, 0); PG8_SCHED; PG8_LDA(At, 1, 0); PG8_STAGE(PG8_SA(0, 1), a2 + hstep, voffA);
            PG8_WAIT_L(8); PG8_BAR; PG8_WAIT_L(0); PG8_MMA(0, 0, At, B0); PG8_BAR; PG8_SCHED;
            PG8_LDB(B1, 1, 1); PG8_STAGE(PG8_SB(1, 0), b3, voffB);
            PG8_BAR; PG8_WAIT_L(0); PG8_MMA(0, 1, At, B1); PG8_BAR;
            PG8_LDA(At, 1, 1); PG8_STAGE(PG8_SA(1, 0), a3, voffA);
            PG8_BAR; PG8_WAIT_L(0); PG8_MMA(1, 0, At, B0); PG8_BAR; PG8_SCHED;
            PG8_STAGE(PG8_SB(1, 1), b3 + hstep, voffB);
            PG8_WAIT_V(6); PG8_BAR; PG8_MMA(1, 1, At, B1); PG8_BAR;
            }
        }
        if constexpr (ALIGN_EPI) { if (wr == 0) PG8_BAR; }
        if constexpr (!Epi::AFTER_DRAIN) { E(acc, cur, wr, wc, fr, fq); S.done(cur); }
        if (!has_next) break;
#pragma unroll
        for (int a = 0; a < 2; ++a)
#pragma unroll
            for (int b = 0; b < 2; ++b)
#pragma unroll
                for (int m = 0; m < 4; ++m)
#pragma unroll
                    for (int n = 0; n < 2; ++n) acc[a][b][m][n] = (f32x4){0.f, 0.f, 0.f, 0.f};
        cur = nxt; cA = nA; cB = nB; ++ui;
        if constexpr (ALIGN_EPI) { if (wr == 1) PG8_BAR; }
    }
    PG8_WAIT_V(0);
    if constexpr (!ALIGN_EPI) { if (wr == 0) PG8_BAR; }
    PG8_BAR;
    if constexpr (Epi::AFTER_DRAIN) { E.fused(acc, cur, wr, wc, fr, fq, lds, wid, lane); S.done(cur); }
#undef PG8_SA
#undef PG8_SB
#undef PG8_STAGE
#undef PG8_LDA
#undef PG8_LDB
#undef PG8_MMA
#undef PG8_WAIT_V
#undef PG8_WAIT_L
#undef PG8_BAR
#undef PG8_SCHED
}
}
#ifndef BIASMODE
#define BIASMODE 3
#endif
namespace att {
typedef unsigned short bf16;
typedef short bf16x8 __attribute__((ext_vector_type(8)));
typedef short s16x4 __attribute__((ext_vector_type(4)));
typedef float f32x16 __attribute__((ext_vector_type(16)));
typedef float f32x4 __attribute__((ext_vector_type(4)));
typedef unsigned u32x4 __attribute__((ext_vector_type(4)));
#define ATT_LAS __attribute__((address_space(3)))
constexpr int D = 128, QPITCH = 128, NSLAB = 96, OPITCH = 4096, SKV = 4096, W = 4096;
constexpr float SCALE = 0.08838834764831845f;
constexpr float INV_SCALE = 11.313708498984761f;
constexpr float THR = 8.f;
constexpr int NW = 8, QBLK = 32, KVBLK = 64, QB = NW * QBLK;
constexpr int SHM_V = KVBLK * D * 2, SHM_K = KVBLK * D * 2;
constexpr int LDS_BODY = 2 * SHM_V + 2 * SHM_K + NW * 64 * 4;
constexpr int LDS_KB = 69632;
constexpr int LDS_REL = LDS_KB + 16384;
constexpr int LDS_PRE = LDS_REL + 2048;
constexpr int LDS_OST = LDS_PRE + 256, OST_ROW = 272, OST_WAVE = 16 * OST_ROW;
constexpr int LDS_BYTES_FOX = LDS_OST + NW * OST_WAVE;
constexpr int REL_N = 272, REL_TOP = 207;

#define KSWZ(row, colB) ((row) * 256 + ((colB) ^ (((row) & 7) << 4)))
#define SBAR() __builtin_amdgcn_sched_barrier(0)
__device__ __forceinline__ int v_st(int k, int c) { const int kk = (k & ~0xC) | ((k & 4) << 1) | ((k & 8) >> 1); return ((kk >> 3) * 4 + (c >> 5)) * 512 + ((kk & 7) * 32 + (c & 31)) * 2; }
__device__ __forceinline__ int v_rd_base(int lane) { return ((lane & 3) << 3) | (((lane >> 2) & 3) << 6) | (((lane >> 4) & 1) << 5) | (((lane >> 5) & 1) << 8); }
constexpr int v_rd_off(int d0, int ks, int half) { return d0 * 512 + ks * 4096 + half * 2048; }
__device__ __forceinline__ int crow(int r, int hi) { return (r & 3) + 8 * (r >> 2) + 4 * hi; }
__device__ __forceinline__ unsigned cvtpk(float lo, float hi) {
    unsigned r; asm volatile("v_cvt_pk_bf16_f32 %0, %1, %2" : "=v"(r) : "v"(lo), "v"(hi)); return r;
}
__device__ __forceinline__ bf16x8 load8(const bf16* p) { return *reinterpret_cast<const bf16x8*>(p); }
__device__ __forceinline__ bf16x8 bld8(__amdgpu_buffer_rsrc_t r, unsigned voff, unsigned soff) { return __builtin_bit_cast(bf16x8, __builtin_amdgcn_raw_buffer_load_b128(r, (int)voff, (int)soff, 0)); }
__device__ __forceinline__ void mask_tile(f32x16& p0, f32x16& p1, int dq) {
    const float NEG = -__builtin_inff();
#pragma unroll
    for (int r = 0; r < 16; ++r) {
        const int c = (r & 3) + 8 * (r >> 2);
        if (dq - c < 0) p0[r] = NEG;
        if (dq - c - 32 < 0) p1[r] = NEG;
    }
}
__device__ __forceinline__ void bias_key(f32x16& p0, f32x16& p1, const ATT_LAS float* kb) {
#pragma unroll
    for (int g = 0; g < 4; ++g) {
        const f32x4 a = *(const ATT_LAS f32x4*)(kb + 8 * g), b = *(const ATT_LAS f32x4*)(kb + 32 + 8 * g);
#pragma unroll
        for (int j = 0; j < 4; ++j) { p0[4 * g + j] += a[j]; p1[4 * g + j] += b[j]; }
    }
}
__device__ __forceinline__ void bias_rel(f32x16& p0, f32x16& p1, const ATT_LAS float* rp) {
#pragma unroll
    for (int r = 0; r < 16; ++r) {
        const int c = (r & 3) + 8 * (r >> 2);
        p0[r] += rp[c]; p1[r] += rp[c + 32];
    }
}
__device__ __forceinline__ void partialSM(f32x16& p0, f32x16& p1, float& m_reg, float& mn, float& alpha) {
    float pmax = p0[0]; for (int r = 1; r < 16; ++r) pmax = fmaxf(pmax, p0[r]); for (int r = 0; r < 16; ++r) pmax = fmaxf(pmax, p1[r]);
    { auto rr = __builtin_amdgcn_permlane32_swap(__float_as_uint(pmax), __float_as_uint(pmax), false, false);
      pmax = fmaxf(__uint_as_float(rr[0]), __uint_as_float(rr[1])); }
    constexpr float C2 = 1.4426950408889634f * SCALE;
    if (__builtin_expect(__all((pmax - m_reg) * SCALE <= THR), 1)) { mn = m_reg; alpha = 1.f; }
    else { mn = fmaxf(m_reg, pmax); alpha = __builtin_amdgcn_exp2f((m_reg - mn) * C2); m_reg = mn; }
    const float mnL = -mn * C2;
    for (int r = 0; r < 16; ++r) p0[r] = fmaf(p0[r], C2, mnL); for (int r = 0; r < 16; ++r) p1[r] = fmaf(p1[r], C2, mnL);
    for (int r = 0; r < 16; ++r) p0[r] = __builtin_amdgcn_exp2f(p0[r]);
}
__device__ __forceinline__ void finishSM(f32x16& p0, f32x16& p1, float alpha, float& l_reg, bf16x8& pa0, bf16x8& pa1, bf16x8& pa2, bf16x8& pa3) {
    for (int r = 0; r < 16; ++r) p1[r] = __builtin_amdgcn_exp2f(p1[r]);
    float ps = 0; for (int r = 0; r < 16; ++r) ps += p0[r]; for (int r = 0; r < 16; ++r) ps += p1[r];
    { auto rr = __builtin_amdgcn_permlane32_swap(__float_as_uint(ps), __float_as_uint(ps), false, false);
      ps = __uint_as_float(rr[0]) + __uint_as_float(rr[1]); }
    l_reg = l_reg * alpha + ps;
#define PK4(P, B_, OUT) do { unsigned a0 = cvtpk(P[B_+0], P[B_+1]), a1 = cvtpk(P[B_+2], P[B_+3]);                          \
        unsigned b0 = cvtpk(P[B_+4], P[B_+5]), b1 = cvtpk(P[B_+6], P[B_+7]);                                             \
        auto r0 = __builtin_amdgcn_permlane32_swap(a0, b0, false, false); auto r1 = __builtin_amdgcn_permlane32_swap(a1, b1, false, false); \
        u32x4 w = {r0[0], r1[0], r0[1], r1[1]}; OUT = *reinterpret_cast<bf16x8*>(&w); } while (0)
    PK4(p0, 0, pa0); PK4(p0, 8, pa1); PK4(p1, 0, pa2); PK4(p1, 8, pa3);
#undef PK4
}
template <int KB>
__device__ __forceinline__ void qkt(f32x16& p0, f32x16& p1, const char* K_lds, int r32, int hi, const bf16x8* qr) {
    p0 = f32x16{}; p1 = f32x16{};
    const char* kb[4];
#pragma unroll
    for (int dd = 0; dd < 4; ++dd) kb[dd] = K_lds + KB * SHM_K + KSWZ(r32, (dd * 16 + hi * 8) * 2);
#pragma unroll
    for (int d0 = 0; d0 < 8; ++d0) { const char* a = kb[d0 & 3] + (d0 >> 2) * 128;
        bf16x8 b0 = *reinterpret_cast<const bf16x8*>(a);
        bf16x8 b1 = *reinterpret_cast<const bf16x8*>(a + 32 * 256);
        p0 = __builtin_amdgcn_mfma_f32_32x32x16_bf16(b0, qr[d0], p0, 0, 0, 0);
        p1 = __builtin_amdgcn_mfma_f32_32x32x16_bf16(b1, qr[d0], p1, 0, 0, 0); }
}
template <int VB>
__device__ __forceinline__ void pv_tile(f32x16* o, int vb0, bf16x8 pa0, bf16x8 pa1, bf16x8 pa2, bf16x8 pa3) {
#define TRRD(dst, off) asm volatile("ds_read_b64_tr_b16 %0, %1 offset:%2" : "=&v"(dst) : "v"(vb0), "i"(off) : "memory")
#define PV_D0(d0) do { s16x4 l0, l1, l2, l3, h0, h1, h2, h3; constexpr int b_ = VB * SHM_V + v_rd_off(d0, 0, 0);     \
        TRRD(l0, b_); TRRD(h0, b_ + 2048); TRRD(l1, b_ + 4096); TRRD(h1, b_ + 6144); TRRD(l2, b_ + 8192); TRRD(h2, b_ + 10240); TRRD(l3, b_ + 12288); TRRD(h3, b_ + 14336); \
        asm volatile("s_waitcnt lgkmcnt(0)" ::: "memory"); SBAR();                                                           \
        o[d0] = __builtin_amdgcn_mfma_f32_32x32x16_bf16(pa0, (bf16x8){l0[0], l0[1], l0[2], l0[3], h0[0], h0[1], h0[2], h0[3]}, o[d0], 0, 0, 0);   \
        o[d0] = __builtin_amdgcn_mfma_f32_32x32x16_bf16(pa1, (bf16x8){l1[0], l1[1], l1[2], l1[3], h1[0], h1[1], h1[2], h1[3]}, o[d0], 0, 0, 0);   \
        o[d0] = __builtin_amdgcn_mfma_f32_32x32x16_bf16(pa2, (bf16x8){l2[0], l2[1], l2[2], l2[3], h2[0], h2[1], h2[2], h2[3]}, o[d0], 0, 0, 0);   \
        o[d0] = __builtin_amdgcn_mfma_f32_32x32x16_bf16(pa3, (bf16x8){l3[0], l3[1], l3[2], l3[3], h3[0], h3[1], h3[2], h3[3]}, o[d0], 0, 0, 0); } while (0)
    PV_D0(0); PV_D0(1); PV_D0(2); PV_D0(3);
#undef PV_D0
#undef TRRD
}

struct BlockRef { int b, P0, qcol, kcol, vcol, ocol, kind, head; };
struct AttnBases { __amdgpu_buffer_rsrc_t prs; bf16* od; bf16* mixed; const float* cumloc; const float* ctot; const float* relt; const float* subg; float lam; };
#define BR_Q(r) ((((unsigned)((r).b * NSLAB + (r).qcol)) << 20) + (unsigned)(r).P0 * 256u)
#define BR_K(r) (((unsigned)((r).b * NSLAB + (r).kcol)) << 20)
#define BR_V(r) (((unsigned)((r).b * NSLAB + (r).vcol)) << 20)
#define BR_O(r) (((r).kind ? AB.mixed : AB.od) + ((size_t)(r).b * SKV + (r).P0) * OPITCH + (r).ocol)
#define BR_CL(r) (AB.cumloc + (size_t)((r).b * 16 + (r).head) * SKV)
#define BR_CT(r) (AB.ctot + ((r).b * 16 + (r).head) * 64)
struct Seam { bf16x8 qr[8]; };
#define VMW() asm volatile("s_waitcnt vmcnt(0)" ::: "memory")
#define FDMA(ldsoff, voffX, src) do { _Pragma("unroll") for (int j_ = 0; j_ < 2; ++j_)                                          \
        __builtin_amdgcn_raw_ptr_buffer_load_lds(AB.prs, (ATT_LAS void*)(ldsL + (ldsoff) + wid * 1024 + j_ * 8192), 16, (int)(voffX), (int)((src) + j_ * 8192), 0, 0); } while (0)
#define FDMA_K(src, bf) FDMA(2 * SHM_V + (bf) * SHM_K, voffK, src)
#define FDMA_V(src, bf) FDMA((bf) * SHM_V, voffV, src)
#define FDMA_OFFS(ln) const unsigned voffK = (unsigned)((4 * wid + ((ln) >> 4)) * 256 + ((((ln) & 15) ^ (4 * (wid & 1) + ((ln) >> 4))) * 16)),                                   \
                     voffV = (unsigned)(((((wid >> 2) * 16 + (((ln) >> 4) & 1) * 8 + ((wid >> 1) & 1) * 4 + (((ln) >> 2) & 3)) * 256) + ((((wid & 1) * 2 + ((ln) >> 5)) * 32 + ((ln) & 3) * 8) * 2)))
__device__ __forceinline__ void attn_prime(const AttnBases& AB, const BlockRef& cur, ATT_LAS unsigned char* ldsL, Seam& S, const int tid) {
    const int wid = __builtin_amdgcn_readfirstlane(tid >> 6), lane = tid & 63, r32 = lane & 31, hi = lane >> 5;
    FDMA_OFFS(lane);
    const unsigned voff_q = (unsigned)((wid * QBLK + r32) * QPITCH + hi * 8) * 2u;
    for (int d0 = 0; d0 < 8; ++d0) S.qr[d0] = bld8(AB.prs, voff_q, BR_Q(cur) + d0 * 32);
    FDMA_K(BR_K(cur), 0); FDMA_K(BR_K(cur) + (unsigned)KVBLK * 256u, 1); FDMA_V(BR_V(cur), 0); VMW();
    __syncthreads();
}
__device__ __forceinline__ void attn_tables(const AttnBases& AB, const BlockRef& cur, ATT_LAS unsigned char* ldsL, const int tid) {
    const float* relt = AB.relt; const float* cl = BR_CL(cur); const float* ct = BR_CT(cur);
    const int lane = tid & 63;
    ATT_LAS float* pre = (ATT_LAS float*)(ldsL + LDS_PRE);
    if (cur.kind == 1) {
        if (tid < 64) { const float v = ct[lane]; float s = v;
#pragma unroll
            for (int o = 1; o < 64; o <<= 1) { const float t = __shfl_up(s, o); if (lane >= o) s += t; }
            pre[lane] = s - v; }
    } else {
        if (tid < REL_N) { const int dist = REL_TOP - tid; float val = 0.f;
            if (dist >= 0) { int bk = dist;
                if (dist >= 16) { const float nf = (float)dist; int lg = 16 + (int)(logf(nf / 16.0f) / 2.0794415416798357f * 16.0f); bk = lg < 31 ? lg : 31; }
                val = (relt[bk * 8 + cur.head] - relt[31 * 8 + cur.head]) * INV_SCALE; }
            ((ATT_LAS float*)(ldsL + LDS_REL))[tid] = val; }
    }
    __syncthreads();
    if (cur.kind == 1) {
        const int k8 = tid * 8;
        if (k8 < cur.P0 + QB) {
            const float cref = pre[cur.P0 >> 6] + cl[cur.P0];
            const float pc = pre[k8 >> 6];
            const f32x4 a = *(const f32x4*)(cl + k8), b = *(const f32x4*)(cl + k8 + 4);
            ATT_LAS f32x4* dst = (ATT_LAS f32x4*)(ldsL + LDS_KB) + tid * 2;
            f32x4 o0, o1;
#pragma unroll
            for (int j = 0; j < 4; ++j) { o0[j] = (cref - (pc + a[j])) * INV_SCALE; o1[j] = (cref - (pc + b[j])) * INV_SCALE; }
            dst[0] = o0; dst[1] = o1;
        }
    }
    __syncthreads();
}
template <int BIASM, int ROLE> __device__ __forceinline__ void attn_block(const AttnBases& AB, const BlockRef& cur, const BlockRef& nxt, char* lds, ATT_LAS unsigned char* ldsL, Seam& S, const int tid) {
    const int wid = __builtin_amdgcn_readfirstlane(tid >> 6), lane = tid & 63, r32 = lane & 31, hi = lane >> 5;
    const int NT = 4 * ((cur.P0 >> 8) + 1);
    const int qlo = cur.P0 + wid * QBLK, qm = qlo + r32 - 4 * hi;
    char* V_lds = lds; char* K_lds = lds + 2 * SHM_V;
    float* ws = (float*)(lds + 2 * SHM_V + 2 * SHM_K) + wid * 64; float* li_l = ws, * al_l = ws + 32;
    float m_reg = -1e30f, l_reg = 0; f32x16 o[4] = {};
    const int vb0 = (int)(uintptr_t)V_lds + v_rd_base(lane);
    const unsigned voff_q = (unsigned)((wid * QBLK + r32) * QPITCH + hi * 8) * 2u;
    FDMA_OFFS(lane);
    const unsigned Kh = BR_K(cur), Vh = BR_V(cur);
    const int kind = cur.kind;
    const ATT_LAS float* kbL = (const ATT_LAS float*)(ldsL + LDS_KB) + 4 * hi;
    const ATT_LAS float* rlL = (const ATT_LAS float*)(ldsL + LDS_REL) + (REL_TOP - qm);
#define RESC(a) do { if (__any((a) < 1.f)) { if (hi == 0) al_l[r32] = (a); asm volatile("s_waitcnt lgkmcnt(0)" ::: "memory");              \
                     for (int d_ = 0; d_ < 4; ++d_) for (int r = 0; r < 16; ++r) o[d_][r] *= al_l[crow(r, hi)]; } } while (0)
#define KBASE(t) ((t) * KVBLK)
#define MASKT(P0_, P1_, t) do { const int kb_ = KBASE(t);                                                                      \
        if (BIASM & 1) { if (kind == 1) bias_key(P0_, P1_, kbL + kb_); }                                                      \
        if (BIASM & 2) { if (kind != 1 && kb_ > qlo - 176 && kb_ <= qlo) bias_rel(P0_, P1_, rlL + kb_); }                         \
        if (kb_ + KVBLK - 1 > qlo) mask_tile(P0_, P1_, qm - kb_); } while (0)
    f32x16 p0, p1; float mn, al; bf16x8 pa0, pa1, pa2, pa3;
#define STEP_DMA(s, SB) do { SBAR(); if ((s) + 2 < NT) FDMA_K(Kh + (unsigned)KBASE((s) + 2) * 256u, SB); FDMA_V(Vh + (unsigned)KBASE((s) + 1) * 256u, 1 - (SB)); SBAR(); } while (0)
#define LAST_DMA() do { SBAR(); FDMA_V(BR_V(nxt), 0); FDMA_K(BR_K(nxt), 0); FDMA_K(BR_K(nxt) + (unsigned)KVBLK * 256u, 1); SBAR();                \
        _Pragma("unroll") for (int d0 = 0; d0 < 8; ++d0) S.qr[d0] = bld8(AB.prs, voff_q, BR_Q(nxt) + d0 * 32); SBAR(); } while (0)
#define LV(t) (KBASE(t) <= qlo + QBLK - 1)
#define SOFTMAX(t) do { MASKT(p0, p1, (t)); partialSM(p0, p1, m_reg, mn, al); finishSM(p0, p1, al, l_reg, pa0, pa1, pa2, pa3); RESC(al); SBAR(); } while (0)
    if (ROLE == 0) {
        qkt<0>(p0, p1, K_lds, r32, hi, S.qr);
        __syncthreads();
#define STEP0(s, SB) do { STEP_DMA(s, SB); SOFTMAX(s);                                                                         \
            qkt<1 - (SB)>(p0, p1, K_lds, r32, hi, S.qr); SBAR(); pv_tile<SB>(o, vb0, pa0, pa1, pa2, pa3);                     \
            VMW(); __syncthreads(); } while (0)
#define STEP0C(s, SB) do { STEP_DMA(s, SB); if (LV(s)) SOFTMAX(s);                                                             \
            if (LV((s) + 1)) qkt<1 - (SB)>(p0, p1, K_lds, r32, hi, S.qr);                                                     \
            SBAR(); if (LV(s)) pv_tile<SB>(o, vb0, pa0, pa1, pa2, pa3);                                                       \
            VMW(); __syncthreads(); } while (0)
        for (int s = 0; s + 4 < NT; s += 2) { STEP0(s, 0); STEP0(s + 1, 1); }
        STEP0C(NT - 4, 0); STEP0C(NT - 3, 1); STEP0C(NT - 2, 0);
        LAST_DMA();
        if (LV(NT - 1)) { SOFTMAX(NT - 1);
            pv_tile<1>(o, vb0, pa0, pa1, pa2, pa3); }
#undef STEP0
#undef STEP0C
    } else {
        qkt<0>(p0, p1, K_lds, r32, hi, S.qr);
        SOFTMAX(0);
        __syncthreads();
#define STEP1(s, SB) do { STEP_DMA(s, SB);                                                                                     \
            qkt<1 - (SB)>(p0, p1, K_lds, r32, hi, S.qr); SBAR(); pv_tile<SB>(o, vb0, pa0, pa1, pa2, pa3);                     \
            SOFTMAX((s) + 1);                                                                                                 \
            VMW(); __syncthreads(); } while (0)
#define STEP1C(s, SB) do { STEP_DMA(s, SB);                                                                                    \
            if (LV((s) + 1)) qkt<1 - (SB)>(p0, p1, K_lds, r32, hi, S.qr);                                                     \
            SBAR(); if (LV(s)) pv_tile<SB>(o, vb0, pa0, pa1, pa2, pa3);                                                       \
            if (LV((s) + 1)) SOFTMAX((s) + 1);                                                                                \
            VMW(); __syncthreads(); } while (0)
        for (int s = 0; s + 4 < NT; s += 2) { STEP1(s, 0); STEP1(s + 1, 1); }
        STEP1C(NT - 4, 0); STEP1C(NT - 3, 1); STEP1C(NT - 2, 0);
        LAST_DMA();
        if (LV(NT - 1)) pv_tile<1>(o, vb0, pa0, pa1, pa2, pa3);
#undef STEP1
#undef STEP1C
    }
    SBAR();
#undef STEP_DMA
#undef LAST_DMA
#undef SOFTMAX
#undef LV
    if (hi == 0) li_l[r32] = l_reg; asm volatile("s_waitcnt lgkmcnt(0)" ::: "memory");
    float rli[16];
#pragma unroll
    for (int r = 0; r < 16; ++r) rli[r] = __builtin_amdgcn_rcpf(li_l[crow(r, hi)]);
    bf16* Ow = BR_O(cur) + (size_t)(wid * QBLK) * OPITCH;
    ATT_LAS unsigned char* ost = ldsL + LDS_OST + wid * OST_WAVE;
    int ln = lane; asm volatile("" : "+v"(ln));
    const int wr_off = (4 * (ln >> 5)) * OST_ROW + (ln & 31) * 2, rd_off = (ln >> 4) * OST_ROW + (ln & 15) * 16;
    const unsigned voff_o = (unsigned)((ln >> 4) * OPITCH + (ln & 15) * 8);
#pragma unroll
    for (int p = 0; p < 2; ++p) {
#pragma unroll
        for (int rr = 0; rr < 8; ++rr) { const int r = 8 * p + rr, row0 = (rr & 3) + 8 * (rr >> 2);
#pragma unroll
            for (int d0 = 0; d0 < 4; d0 += 2) { const unsigned w = cvtpk(o[d0][r] * rli[r], o[d0 + 1][r] * rli[r]);
                *(ATT_LAS unsigned short*)(ost + wr_off + row0 * OST_ROW + d0 * 64) = (unsigned short)(w & 0xffffu);
                *(ATT_LAS unsigned short*)(ost + wr_off + row0 * OST_ROW + (d0 + 1) * 64) = (unsigned short)(w >> 16); } }
        asm volatile("s_waitcnt lgkmcnt(0)" ::: "memory");
        u32x4 ch[4];
#pragma unroll
        for (int j = 0; j < 4; ++j) ch[j] = *(const ATT_LAS u32x4*)(ost + rd_off + (4 * j) * OST_ROW);
        asm volatile("s_waitcnt lgkmcnt(0)" ::: "memory");
#pragma unroll
        for (int j = 0; j < 4; ++j) *(u32x4*)(Ow + (size_t)(16 * p + 4 * j) * OPITCH + voff_o) = ch[j];
    }
    VMW(); __syncthreads();
#undef RESC
#undef KBASE
#undef MASKT
}
constexpr int D2_K = 0, D2_VA = 32768, D2_VB = 65536, D2_P = 98304, D2_PSLOT = 4352, D2_LI = D2_P + 8 * D2_PSLOT, D2_WS = D2_LI + 512, D2_REL = D2_WS + 1024, D2_SS = D2_REL + 2048  , D2_BYTES = D2_SS + 1024;
constexpr int D2_QB = 128;
struct Ref2 { int b, P0, qcol, kcol, vcol, head, m; };
__device__ __forceinline__ void diff_block(const AttnBases& AB, const Ref2& R, char* lds, ATT_LAS unsigned char* ldsL, const int tid) {
    const int wid = __builtin_amdgcn_readfirstlane(tid >> 6), lane = tid & 63, r32 = lane & 31, hi = lane >> 5;
    const bool isA = wid < 4; const int g = wid & 3;
    const int NT = 2 * ((R.P0 >> 7) + 1);
    const unsigned Qb = (((unsigned)(R.b * NSLAB + R.qcol)) << 20) + (unsigned)R.P0 * 256u;
    const unsigned Kh = ((unsigned)(R.b * NSLAB + R.kcol)) << 20;
    const unsigned Vh = ((unsigned)(R.b * NSLAB + R.vcol)) << 20;
    const int qlo = R.P0 + g * QBLK, qm = qlo + r32 - 4 * hi;
    char* K_lds = lds + D2_K;
    const int vbA = (int)(uintptr_t)(lds + D2_VA) + v_rd_base(lane), vbB = (int)(uintptr_t)(lds + D2_VB) + v_rd_base(lane);
    ATT_LAS float* al_l = (ATT_LAS float*)(ldsL + D2_WS) + g * 64;
    ATT_LAS float* liS = (ATT_LAS float*)(ldsL + D2_LI) + g * 32;
    const ATT_LAS float* rlL = (const ATT_LAS float*)(ldsL + D2_REL) + (REL_TOP - qm);
    const int wb = wid & 3;
    f32x16 o[4] = {};
#define D2_BAR() do { asm volatile("s_waitcnt lgkmcnt(0)" ::: "memory"); __builtin_amdgcn_s_barrier(); asm volatile("" ::: "memory"); } while (0)
#define VMW() asm volatile("s_waitcnt vmcnt(0)" ::: "memory")
#define KBASE(t) ((t) * KVBLK)
#define PSLOT(buf) (ldsL + D2_P + (g * 2 + (buf)) * D2_PSLOT)
#define DMA_TILE(ldsoff, voffX, src) do { _Pragma("unroll") for (int j_ = 0; j_ < 4; ++j_)                                    \
        __builtin_amdgcn_raw_ptr_buffer_load_lds(AB.prs, (ATT_LAS void*)(ldsL + (ldsoff) + wb * 1024 + j_ * 4096), 16, (int)(voffX), (int)((src) + j_ * 4096), 0, 0); } while (0)
#define DMA_K(t, bf)  DMA_TILE(D2_K + (bf) * SHM_K, voffK, Kh + (unsigned)KBASE(t) * 256u)
#define DMA_VA(t, bf) DMA_TILE(D2_VA + (bf) * SHM_V, voffV, Vh + (unsigned)KBASE(t) * 256u)
#define DMA_VB(t, bf) DMA_TILE(D2_VB + (bf) * SHM_V, voffV, Vh + (1u << 20) + (unsigned)KBASE(t) * 256u)
#define RESC(a) do { if (__any((a) < 1.f)) { if (hi == 0) al_l[r32] = (a); asm volatile("s_waitcnt lgkmcnt(0)" ::: "memory");              \
                     for (int d_ = 0; d_ < 4; ++d_) for (int r = 0; r < 16; ++r) o[d_][r] *= al_l[crow(r, hi)]; } } while (0)
#define MASKT(P0_, P1_, t) do { const int kb_ = KBASE(t);                                                                      \
        if (kb_ > qlo - 176 && kb_ <= qlo) bias_rel(P0_, P1_, rlL + kb_);                                                      \
        if (kb_ + KVBLK - 1 > qlo) mask_tile(P0_, P1_, qm - kb_); } while (0)
#define P_PUT(buf, alY) do { ATT_LAS unsigned char* s_ = PSLOT(buf);                                                            \
        *(ATT_LAS bf16x8*)(s_ + lane * 16) = pa0; *(ATT_LAS bf16x8*)(s_ + 1024 + lane * 16) = pa1;                            \
        *(ATT_LAS bf16x8*)(s_ + 2048 + lane * 16) = pa2; *(ATT_LAS bf16x8*)(s_ + 3072 + lane * 16) = pa3;                     \
        if (hi == 0) *(ATT_LAS float*)(s_ + 4096 + r32 * 4) = (alY);                                                          \
        const int any_ = __any((alY) < 1.f) ? 1 : 0; if (lane == 0) *(ATT_LAS int*)(s_ + 4224) = any_; } while (0)
#define P_GET_PV(buf) do { const ATT_LAS unsigned char* s_ = PSLOT(buf);                                                       \
        pa0 = *(const ATT_LAS bf16x8*)(s_ + lane * 16); pa1 = *(const ATT_LAS bf16x8*)(s_ + 1024 + lane * 16);               \
        pa2 = *(const ATT_LAS bf16x8*)(s_ + 2048 + lane * 16); pa3 = *(const ATT_LAS bf16x8*)(s_ + 3072 + lane * 16);        \
        const int any_ = __builtin_amdgcn_readfirstlane(*(const ATT_LAS int*)(s_ + 4224));                                    \
        if (any_) { _Pragma("unroll") for (int gq = 0; gq < 4; ++gq) { const f32x4 a_ = *(const ATT_LAS f32x4*)(s_ + 4096 + (8 * gq + 4 * hi) * 4);       \
                _Pragma("unroll") for (int d_ = 0; d_ < 4; ++d_) _Pragma("unroll") for (int j_ = 0; j_ < 4; ++j_) o[d_][4 * gq + j_] *= a_[j_]; } }     \
        asm volatile("s_waitcnt lgkmcnt(0)" ::: "memory"); SBAR();                                                            \
        pv_tile<buf>(o, vbB, pa0, pa1, pa2, pa3); } while (0)
    if (tid < REL_N) { const int dist = REL_TOP - tid; float val = 0.f;
        if (dist >= 0) { int bk = dist;
            if (dist >= 16) { const float nf = (float)dist; int lg = 16 + (int)(logf(nf / 16.0f) / 2.0794415416798357f * 16.0f); bk = lg < 31 ? lg : 31; }
            val = (AB.relt[bk * 8 + R.head] - AB.relt[31 * 8 + R.head]) * INV_SCALE; }
        ((ATT_LAS float*)(ldsL + D2_REL))[tid] = val; }
    if (isA) {
        float m_reg = -1e30f, l_reg = 0.f; bf16x8 qr[8];
        f32x16 pA0, pA1, pB0, pB1; float mnA, mnB, alA = 1.f, alB = 1.f; bf16x8 pa0, pa1, pa2, pa3;
#pragma unroll
        for (int d0 = 0; d0 < 8; ++d0) qr[d0] = bld8(AB.prs, (unsigned)((g * QBLK + r32) * QPITCH + hi * 8) * 2u, Qb + d0 * 32);
        D2_BAR();
        SBAR(); qkt<0>(pA0, pA1, K_lds, r32, hi, qr); MASKT(pA0, pA1, 0); partialSM(pA0, pA1, m_reg, mnA, alA);
        D2_BAR();
#define STEP_A(PX0, PX1, mnX, alX, PY0, PY1, alY, t, KB, PVB) do {                                                             \
            SBAR(); qkt<KB>(PX0, PX1, K_lds, r32, hi, qr);                                                                    \
            finishSM(PY0, PY1, alY, l_reg, pa0, pa1, pa2, pa3); SBAR();                                                       \
            P_PUT(PVB, alY);                                                                                                  \
            pv_tile<PVB>(o, vbA, pa0, pa1, pa2, pa3); MASKT(PX0, PX1, (t)); partialSM(PX0, PX1, m_reg, mnX, alX);             \
            RESC(alX); D2_BAR(); } while (0)
        for (int t = 1; t + 1 < NT; t += 2) {
            STEP_A(pB0, pB1, mnB, alB, pA0, pA1, alA, t, 1, 0);
            STEP_A(pA0, pA1, mnA, alA, pB0, pB1, alB, t + 1, 0, 1);
        }
        const bool lvL = KBASE(NT - 1) <= qlo + QBLK - 1;
        SBAR(); if (lvL) qkt<1>(pB0, pB1, K_lds, r32, hi, qr);
        finishSM(pA0, pA1, alA, l_reg, pa0, pa1, pa2, pa3); SBAR();
        P_PUT(0, alA);
        pv_tile<0>(o, vbA, pa0, pa1, pa2, pa3);
        if (lvL) { MASKT(pB0, pB1, NT - 1); partialSM(pB0, pB1, m_reg, mnB, alB); RESC(alB); }
        D2_BAR();
        if (lvL) { finishSM(pB0, pB1, alB, l_reg, pa0, pa1, pa2, pa3); SBAR(); P_PUT(1, alB); pv_tile<1>(o, vbA, pa0, pa1, pa2, pa3); }
        if (hi == 0) liS[r32] = l_reg;
        D2_BAR();
#undef STEP_A
    } else {
        bf16x8 pa0, pa1, pa2, pa3;
        int lb = lane; asm volatile("" : "+v"(lb));
        const unsigned voffK = (unsigned)((4 * wb + (lb >> 4)) * 256 + (((lb & 15) ^ (4 * (wb & 1) + (lb >> 4))) * 16));
        const unsigned voffV = (unsigned)(((((lb >> 4) & 1) * 8 + ((wb >> 1) & 1) * 4 + ((lb >> 2) & 3)) * 256) + ((((wb & 1) * 2 + (lb >> 5)) * 32 + (lb & 3) * 8) * 2));
        DMA_K(0, 0); VMW();
        D2_BAR();
        DMA_K(1, 1); DMA_VA(0, 0); VMW();
        D2_BAR();
#define STEP_B(t, KB, PVB) do {                                                                                                \
            if ((t) + 1 < NT) DMA_K((t) + 1, PVB); DMA_VA(t, KB); DMA_VB((t) - 1, PVB); SBAR();                               \
            if ((t) >= 2) P_GET_PV(KB);                                                                                       \
            VMW(); D2_BAR(); } while (0)
        for (int t = 1; t + 1 < NT; t += 2) { STEP_B(t, 1, 0); STEP_B(t + 1, 0, 1); }
        STEP_B(NT - 1, 1, 0);
        DMA_VB(NT - 1, 1);
        P_GET_PV(0);
        VMW(); D2_BAR();
        if (KBASE(NT - 1) <= qlo + QBLK - 1) P_GET_PV(1);
#undef STEP_B
    }
    {   float rli[16];
#pragma unroll
        for (int r = 0; r < 16; ++r) rli[r] = __builtin_amdgcn_rcpf(liS[crow(r, hi)]);
        const int hfw = isA ? 0 : 1;
        bf16* O1w = AB.od + ((size_t)R.b * SKV + R.P0 + g * QBLK) * OPITCH + R.head * 512 + hfw * 128;
        bf16* Mw = AB.mixed + ((size_t)R.b * SKV + R.P0 + g * QBLK) * OPITCH + R.head * 256 + hfw * 128;
        ATT_LAS unsigned char* ost = ldsL + (isA ? D2_K : D2_VA) + g * OST_WAVE;
        int ln = lane; asm volatile("" : "+v"(ln));
        const int wr_off = (4 * (ln >> 5)) * OST_ROW + (ln & 31) * 2, rd_off = (ln >> 4) * OST_ROW + (ln & 15) * 16;
        const unsigned voff_o = (unsigned)((ln >> 4) * OPITCH + (ln & 15) * 8);
#define D2_STAGE(p) do { _Pragma("unroll") for (int rr = 0; rr < 8; ++rr) { const int r = 8 * (p) + rr, row0 = (rr & 3) + 8 * (rr >> 2);                                   \
            _Pragma("unroll") for (int d0 = 0; d0 < 4; d0 += 2) { const unsigned w = cvtpk(o[d0][r] * rli[r], o[d0 + 1][r] * rli[r]);                                        \
                *(ATT_LAS unsigned short*)(ost + wr_off + row0 * OST_ROW + d0 * 64) = (unsigned short)(w & 0xffffu);                                                        \
                *(ATT_LAS unsigned short*)(ost + wr_off + row0 * OST_ROW + (d0 + 1) * 64) = (unsigned short)(w >> 16); } }                                                  \
        asm volatile("s_waitcnt lgkmcnt(0)" ::: "memory");                                                                                                                  \
        _Pragma("unroll") for (int j = 0; j < 4; ++j) ch[j] = *(const ATT_LAS u32x4*)(ost + rd_off + (4 * j) * OST_ROW);                                                    \
        asm volatile("s_waitcnt lgkmcnt(0)" ::: "memory"); } while (0)
        if (R.m == 0) {
#pragma unroll
            for (int p = 0; p < 2; ++p) { u32x4 ch[4]; D2_STAGE(p);
#pragma unroll
                for (int j = 0; j < 4; ++j) *(u32x4*)(O1w + (size_t)(16 * p + 4 * j) * OPITCH + voff_o) = ch[j]; }
            asm volatile("s_waitcnt vmcnt(0)" ::: "memory");
        } else {
            const f32x4 gm0 = *(const f32x4*)(AB.subg + hfw * 128 + (ln & 15) * 8), gm1 = *(const f32x4*)(AB.subg + hfw * 128 + (ln & 15) * 8 + 4);
            ATT_LAS float* ssMine = (ATT_LAS float*)(ldsL + D2_SS) + (hfw * 4 + g) * 32;
            const ATT_LAS float* ssPeer = (const ATT_LAS float*)(ldsL + D2_SS) + ((1 - hfw) * 4 + g) * 32;
            float dv[2][4][8], ssr[2][4];
#pragma unroll
            for (int p = 0; p < 2; ++p) { u32x4 ch[4], q1[4];
#pragma unroll
                for (int j = 0; j < 4; ++j) q1[j] = *(const u32x4*)(O1w + (size_t)(16 * p + 4 * j) * OPITCH + voff_o);
                D2_STAGE(p);
#pragma unroll
                for (int j = 0; j < 4; ++j) { float ss = 0.f;
#pragma unroll
                    for (int e = 0; e < 4; ++e) { const unsigned a = q1[j][e], b = ch[j][e];
                        const float d0_ = __uint_as_float(a << 16) - AB.lam * __uint_as_float(b << 16), d1_ = __uint_as_float(a & 0xffff0000u) - AB.lam * __uint_as_float(b & 0xffff0000u);
                        dv[p][j][2 * e] = d0_; dv[p][j][2 * e + 1] = d1_; ss += d0_ * d0_ + d1_ * d1_; }
                    ss += __shfl_xor(ss, 1); ss += __shfl_xor(ss, 2); ss += __shfl_xor(ss, 4); ss += __shfl_xor(ss, 8);
                    ssr[p][j] = ss;
                    if ((ln & 15) == 0) ssMine[16 * p + 4 * j + (ln >> 4)] = ss; } }
            D2_BAR();
#pragma unroll
            for (int p = 0; p < 2; ++p)
#pragma unroll
                for (int j = 0; j < 4; ++j) { const float tot = ssr[p][j] + ssPeer[16 * p + 4 * j + (ln >> 4)];
                    const float rs = 0.8f / sqrtf(tot * (1.0f / 256.0f) + 1e-6f);
                    u32x4 w;
                    w.x = cvtpk(dv[p][j][0] * rs * gm0[0], dv[p][j][1] * rs * gm0[1]); w.y = cvtpk(dv[p][j][2] * rs * gm0[2], dv[p][j][3] * rs * gm0[3]);
                    w.z = cvtpk(dv[p][j][4] * rs * gm1[0], dv[p][j][5] * rs * gm1[1]); w.w = cvtpk(dv[p][j][6] * rs * gm1[2], dv[p][j][7] * rs * gm1[3]);
                    *(u32x4*)(Mw + (size_t)(16 * p + 4 * j) * OPITCH + voff_o) = w; }
        }
#undef D2_STAGE
    }
    D2_BAR();
#undef D2_BAR
#undef VMW
#undef KBASE
#undef PSLOT
#undef DMA_TILE
#undef DMA_K
#undef DMA_VA
#undef DMA_VB
#undef RESC
#undef MASKT
#undef P_PUT
#undef P_GET_PV
}
#undef BR_Q
#undef BR_K
#undef BR_V
#undef BR_O
#undef BR_CL
#undef BR_CT
#undef VMW
#undef FDMA
#undef FDMA_K
#undef FDMA_V
#undef FDMA_OFFS
constexpr int LDS_BYTES = D2_BYTES > LDS_BYTES_FOX ? D2_BYTES : LDS_BYTES_FOX;
}

constexpr int NWAVES = 8;
constexpr int BATCH = 4, SEQ = 4096, DM = 4096, M = BATCH * SEQ;
constexpr int NQKV = 12288, INCOLS = 12304, NFH = 16, DFF = 11008, NGU = 2 * DFF;
constexpr float EPS = 1e-6f;

constexpr size_t MiB = 1u << 20;
constexpr size_t WS_CTL = 0, CTL_ZERO_BYTES = 1 * MiB;
constexpr size_t WS_CUMLOC = 1 * MiB;
constexpr size_t WS_CTOT = 2 * MiB;
constexpr size_t WS_WFT = 3 * MiB;
constexpr size_t WS_WIN = 8 * MiB;
constexpr size_t WS_WO = 104 * MiB;
constexpr size_t WS_WGU = 136 * MiB;
constexpr size_t WS_WD = 308 * MiB;
constexpr size_t WS_A = 394 * MiB;
constexpr size_t WS_B = 522 * MiB;
constexpr size_t WS_XB = WS_B + 344 * MiB;
constexpr size_t WS_END = 994 * MiB;
static_assert(WS_WIN + (size_t)NQKV * DM * 2 <= WS_WO && WS_WO + (size_t)DM * DM * 2 <= WS_WGU && WS_WGU + (size_t)NGU * DM * 2 <= WS_WD && WS_WD + (size_t)DM * DFF * 2 <= WS_A
              && WS_A + (size_t)M * DM * 2 <= WS_B && WS_B + (size_t)M * NQKV * 2 <= WS_END && WS_B + (size_t)M * DFF * 2 <= WS_XB && WS_XB + (size_t)M * DM * 2 <= WS_END, "d_ws map");
constexpr int CW_TMO = 0, CW_CODE = 1;
constexpr int CW_BAR = 4096;
constexpr int CW_ROWSS = 65536;
static_assert((CW_ROWSS + 2 * M) * 4 <= (int)CTL_ZERO_BYTES, "CTL words (rowss, then rms of the input rows) inside the memset region");

constexpr int RING_OFF = 0, RING_BYTES = 131072;
constexpr int LDSCTL_OFF = 139264, MISC_OFF = LDSCTL_OFF + 320;
constexpr int LDS_BYTES = 147456;
static_assert(MISC_OFF + 128 <= LDS_BYTES && att::LDS_BYTES <= LDSCTL_OFF && RING_BYTES <= LDSCTL_OFF, "LDS map");

#define GAS __attribute__((address_space(1)))
#define LAS __attribute__((address_space(3)))
typedef unsigned short bf16;
typedef unsigned v4u __attribute__((ext_vector_type(4)));
typedef float f32x4 __attribute__((ext_vector_type(4)));
typedef short bf16x8 __attribute__((ext_vector_type(8)));
typedef GAS unsigned gu32;
#define RLX_AGENT __ATOMIC_RELAXED, __HIP_MEMORY_SCOPE_AGENT
#define LDS_WAIT() asm volatile("s_waitcnt lgkmcnt(0)" ::: "memory")
#define VM_WAIT() asm volatile("s_waitcnt vmcnt(0)" ::: "memory")
__device__ __forceinline__ unsigned f2bf(float f) { unsigned u = __builtin_bit_cast(unsigned, f); return (u + 0x7fffu + ((u >> 16) & 1u)) >> 16; }
__device__ __forceinline__ unsigned pk2(float lo, float hi) { return f2bf(lo) | (f2bf(hi) << 16); }
__device__ __forceinline__ float bf2f(short s) { return __builtin_bit_cast(float, ((unsigned)(unsigned short)s) << 16); }

#define XB_TMO      128
#define XB_XCNT(j)  (256  + 64 * (j))
#define XB_XSUB(j)  (1280 + 64 * (j))
#define XB_XGEN(j)  (2304 + 64 * (j))
#define XB_TOP      3328
#define XB_TOPGEN   3392
#define XCD_BAR_WORDS 3456
#define XB_SPIN_CAP (1u << 18)

__device__ __forceinline__ unsigned xb_ld(unsigned* p)              { return __hip_atomic_load(p, __ATOMIC_RELAXED, __HIP_MEMORY_SCOPE_AGENT); }
__device__ __forceinline__ unsigned xb_add(unsigned* p, unsigned v) { return __hip_atomic_fetch_add(p, v, __ATOMIC_RELAXED, __HIP_MEMORY_SCOPE_AGENT); }
__device__ __forceinline__ unsigned xb_xcc_id() { return (unsigned)__builtin_amdgcn_s_getreg((3 << 11) | 20) & 0xFu; }
#define XB_SPIN(cond, bar) do { unsigned _sp = 0; while (cond) { __builtin_amdgcn_s_sleep(1); \
    if ((++_sp & 255u) == 0u) { if (xb_ld(&(bar)[XB_TMO])) break; if (_sp > XB_SPIN_CAP) { atomicAdd(&(bar)[XB_TMO], 1u); break; } } } } while (0)

struct XcdBarrier {
    unsigned* bar; unsigned x;
    volatile LAS unsigned* st;
};

__device__ __forceinline__ XcdBarrier xcd_barrier_post(unsigned* bar, volatile LAS unsigned* st) {
    XcdBarrier b; b.bar = bar; b.x = xb_xcc_id(); b.st = st;
    if (threadIdx.x == 0) (void)xb_add(&bar[XB_XCNT(b.x)], 1u);
    return b;
}
__device__ __forceinline__ void xcd_barrier_complete(unsigned* bar, unsigned x, unsigned& nloc, unsigned& nx) {
    const unsigned G = gridDim.x * gridDim.y * gridDim.z;
    unsigned sum, cnt, mine, sp = 0u;
    for (;;) {
        sum = 0u; cnt = 0u; mine = 0u;
#pragma unroll
        for (unsigned j = 0; j < 16; ++j) { const unsigned c = xb_ld(&bar[XB_XCNT(j)]); sum += c; cnt += (c > 0u) ? 1u : 0u; mine = (j == x) ? c : mine; }
        if (sum == G) break;
        __builtin_amdgcn_s_sleep(1);
        if ((++sp & 255u) == 0u) { if (xb_ld(&bar[XB_TMO])) break; if (sp > XB_SPIN_CAP) { atomicAdd(&bar[XB_TMO], 1u); break; } }
    }
    nloc = mine > 0u ? mine : 1u; nx = cnt > 0u ? cnt : 1u;
}

__device__ __forceinline__ void xcd_barrier(const XcdBarrier& b) {
    asm volatile("s_waitcnt vmcnt(0)" ::: "memory");
    __syncthreads();
    if (threadIdx.x == 0) {
        unsigned* bar = b.bar;
        __builtin_amdgcn_s_waitcnt(0);
        unsigned nloc = b.st[0], nx = b.st[1];
        if (nloc == 0u) { xcd_barrier_complete(bar, b.x, nloc, nx); b.st[0] = nloc; b.st[1] = nx; }
        const unsigned old = xb_add(&bar[XB_XSUB(b.x)], 1u);
        const unsigned gen = old / nloc;
        if (old + 1u == (gen + 1u) * nloc) {
            __builtin_amdgcn_fence(__ATOMIC_RELEASE, "agent");
            asm volatile("s_waitcnt vmcnt(0)" ::: "memory");
            const unsigned og = xb_add(&bar[XB_TOP], 1u);
            const unsigned tg = og / nx;
            if (og + 1u == (tg + 1u) * nx) xb_add(&bar[XB_TOPGEN], 1u);
            else XB_SPIN(xb_ld(&bar[XB_TOPGEN]) == tg, bar);
            __builtin_amdgcn_fence(__ATOMIC_ACQUIRE, "agent");
            xb_add(&bar[XB_XGEN(b.x)], 1u);
            asm volatile("s_waitcnt vmcnt(0)" ::: "memory");
        } else {
            XB_SPIN(xb_ld(&bar[XB_XGEN(b.x)]) == gen, bar);
            __builtin_amdgcn_fence(__ATOMIC_ACQUIRE, "agent");
            asm volatile("s_waitcnt vmcnt(0)" ::: "memory");
        }
    }
    __syncthreads();
}

struct Frame {
    LAS unsigned char* lds;
    volatile LAS unsigned* MISC;
    gu32* ctl;
    int tid, lane, wave;
    int vcu, G;
    const float *x, *g_attn, *w_in, *b_f, *lq1, *lk1, *lq2, *lk2, *relt, *subg, *w_o, *g_ffn, *w_gate, *w_up, *w_down, *g_final;
    float* out;
    bf16 *Win_t, *WfT, *Wo_t, *Wgu_t, *Wd_t, *bufA, *bufB, *od, *xb, *mx;
    float* rinv;
    float *cumloc, *ctot;
};
__device__ __forceinline__ float wave_sum(float v) {
    const int ln = pg8::fresh_lane();
#pragma unroll
    for (int o = 1; o < 64; o <<= 1) v += __builtin_bit_cast(float, __builtin_amdgcn_ds_bpermute((ln ^ o) << 2, __builtin_bit_cast(int, v)));
    return v;
}
template <bool GAIN> __device__ __forceinline__ void transpose_item(const float* W, int ldw, int k0, int n0, bf16* WT, int Kdst, int drow0, LAS float* scr, int lane, const float* gk = nullptr) {
#pragma unroll 8
    for (int i = 0; i < 32; ++i) { const int kk = 2 * i + (lane >> 5); scr[kk * 33 + (lane & 31)] = W[(size_t)(k0 + kk) * ldw + n0 + (lane & 31)]; }
    LDS_WAIT(); asm volatile("" ::: "memory");
    const int c = lane & 7;
    f32x4 g0 = {1.f, 1.f, 1.f, 1.f}, g1 = g0;
    if (GAIN) { g0 = *(const GAS f32x4*)(gk + k0 + 8 * c); g1 = *(const GAS f32x4*)(gk + k0 + 8 * c + 4); }
#pragma unroll
    for (int j = 0; j < 4; ++j) { const int n = (lane >> 3) + 8 * j; const LAS float* s = scr + (8 * c) * 33 + n;
        v4u o; o.x = pk2(s[0 * 33] * g0.x, s[1 * 33] * g0.y); o.y = pk2(s[2 * 33] * g0.z, s[3 * 33] * g0.w); o.z = pk2(s[4 * 33] * g1.x, s[5 * 33] * g1.y); o.w = pk2(s[6 * 33] * g1.z, s[7 * 33] * g1.w);
        *(GAS v4u*)(WT + (size_t)(drow0 + n) * Kdst + k0 + 8 * c) = o; }
    LDS_WAIT(); asm volatile("" ::: "memory");
}
template <bool OUT_BF16> __device__ __forceinline__ void norm_rows(Frame& F, const float* X, const float* g, void* out, bool bad) {
    const int tid = pg8::fresh_tid(F.wave), lane = tid & 63, wave = __builtin_amdgcn_readfirstlane(tid >> 6);
    const int gw = F.vcu * NWAVES + wave, NGW = F.G * NWAVES;
    f32x4 gv[16];
#pragma unroll
    for (int j = 0; j < 16; ++j) gv[j] = ((const GAS f32x4*)g)[lane + 64 * j];
    for (int m = gw; m < M; m += NGW) {
        const GAS f32x4* xr = (const GAS f32x4*)(X + (size_t)m * DM) + lane;
        f32x4 v[16]; float s = 0.f;
#pragma unroll
        for (int j = 0; j < 16; ++j) { v[j] = xr[64 * j]; s += (v[j].x * v[j].x + v[j].y * v[j].y) + (v[j].z * v[j].z + v[j].w * v[j].w); }
        float r = 1.0f / sqrtf(wave_sum(s) * (1.0f / DM) + EPS);
        if (bad) r = __builtin_nanf("");
        if (OUT_BF16) { GAS unsigned long long* o8 = (GAS unsigned long long*)((bf16*)out + (size_t)m * DM) + lane;
#pragma unroll
            for (int j = 0; j < 16; ++j) o8[64 * j] = (unsigned long long)pk2(v[j].x * r * gv[j].x, v[j].y * r * gv[j].y) | ((unsigned long long)pk2(v[j].z * r * gv[j].z, v[j].w * r * gv[j].w) << 32);
        } else { GAS f32x4* o = (GAS f32x4*)((float*)out + (size_t)m * DM) + lane;
#pragma unroll
            for (int j = 0; j < 16; ++j) o[64 * j] = (v[j] * r) * gv[j]; }
    }
}
__device__ __forceinline__ void rows_to_bf16(Frame& F, const float* X, bf16* out, float* rinv) {
    const int tid = pg8::fresh_tid(F.wave), lane = tid & 63, wave = __builtin_amdgcn_readfirstlane(tid >> 6);
    const int gw = F.vcu * NWAVES + wave, NGW = F.G * NWAVES;
    for (int m = gw; m < M; m += NGW) {
        const GAS f32x4* xr = (const GAS f32x4*)(X + (size_t)m * DM) + lane;
        f32x4 v[16]; float s = 0.f;
#pragma unroll
        for (int j = 0; j < 16; ++j) { v[j] = xr[64 * j]; s += (v[j].x * v[j].x + v[j].y * v[j].y) + (v[j].z * v[j].z + v[j].w * v[j].w); }
        const float r = 1.0f / sqrtf(wave_sum(s) * (1.0f / DM) + EPS);
        if (lane == 0) rinv[m] = r;
        GAS unsigned long long* o8 = (GAS unsigned long long*)(out + (size_t)m * DM) + lane;
#pragma unroll
        for (int j = 0; j < 16; ++j) o8[64 * j] = (unsigned long long)pk2(v[j].x, v[j].y) | ((unsigned long long)pk2(v[j].z, v[j].w) << 32);
    }
}
__device__ __forceinline__ void norm_rows_bf16in(Frame& F, const bf16* X, const float* g, float* out, bool bad) {
    const int tid = pg8::fresh_tid(F.wave), lane = tid & 63, wave = __builtin_amdgcn_readfirstlane(tid >> 6);
    const int gw = F.vcu * NWAVES + wave, NGW = F.G * NWAVES;
    f32x4 gv[16];
#pragma unroll
    for (int j = 0; j < 8; ++j) { gv[2 * j] = ((const GAS f32x4*)g)[2 * (lane + 64 * j)]; gv[2 * j + 1] = ((const GAS f32x4*)g)[2 * (lane + 64 * j) + 1]; }
    for (int m = gw; m < M; m += NGW) {
        const GAS v4u* xr = (const GAS v4u*)(X + (size_t)m * DM) + lane;
        f32x4 v[16]; float s = 0.f;
#pragma unroll
        for (int j = 0; j < 8; ++j) { const v4u w = xr[64 * j];
            v[2 * j] = (f32x4){__uint_as_float(w.x << 16), __uint_as_float(w.x & 0xffff0000u), __uint_as_float(w.y << 16), __uint_as_float(w.y & 0xffff0000u)};
            v[2 * j + 1] = (f32x4){__uint_as_float(w.z << 16), __uint_as_float(w.z & 0xffff0000u), __uint_as_float(w.w << 16), __uint_as_float(w.w & 0xffff0000u)}; }
#pragma unroll
        for (int j = 0; j < 16; ++j) s += (v[j].x * v[j].x + v[j].y * v[j].y) + (v[j].z * v[j].z + v[j].w * v[j].w);
        float r = 1.0f / sqrtf(wave_sum(s) * (1.0f / DM) + EPS);
        if (bad) r = __builtin_nanf("");
        GAS f32x4* o = (GAS f32x4*)(out + (size_t)m * DM) + 2 * lane;
#pragma unroll
        for (int j = 0; j < 8; ++j) { o[128 * j] = (v[2 * j] * r) * gv[2 * j]; o[128 * j + 1] = (v[2 * j + 1] * r) * gv[2 * j + 1]; }
    }
}
__device__ __forceinline__ void p0_prologue(Frame& F) {
    const int tid = pg8::fresh_tid(F.wave), lane = tid & 63, wave = __builtin_amdgcn_readfirstlane(tid >> 6);
    LAS float* scr = (LAS float*)(F.lds + RING_OFF + wave * 16384);
    const int gw = F.vcu * NWAVES + wave, NGW = F.G * NWAVES;
    constexpr int KB4 = DM / 64, KBF = DFF / 64;
    constexpr int I_IN = KB4 * (NQKV / 32), I_O = KB4 * (DM / 32), I_G = KB4 * (DFF / 32), I_D = KBF * (DM / 32);
    constexpr int NITEMS = I_IN + I_O + 2 * I_G;
    for (int it = gw; it < NITEMS; it += NGW) {
        int r = it;
        if (r < I_IN) { const int nblk = NQKV / 32, kb = r / nblk, nb = r % nblk; transpose_item<true>(F.w_in, INCOLS, 64 * kb, 32 * nb, F.Win_t, DM, 32 * nb, scr, lane, F.g_attn); continue; } r -= I_IN;
        if (r < I_O) { const int nblk = DM / 32, kb = r / nblk, nb = r % nblk; transpose_item<false>(F.w_o, DM, 64 * kb, 32 * nb, F.Wo_t, DM, 32 * nb, scr, lane); continue; } r -= I_O;
        if (r < I_G) { const int nblk = DFF / 32, kb = r / nblk, nb = r % nblk, n0 = 32 * nb; transpose_item<true>(F.w_gate, DFF, 64 * kb, n0, F.Wgu_t, DM, (n0 >> 7) * 256 + (n0 & 127), scr, lane, F.g_ffn); continue; } r -= I_G;
        { const int nblk = DFF / 32, kb = r / nblk, nb = r % nblk, n0 = 32 * nb; transpose_item<true>(F.w_up, DFF, 64 * kb, n0, F.Wgu_t, DM, (n0 >> 7) * 256 + 128 + (n0 & 127), scr, lane, F.g_ffn); }
    }
    for (int i = gw * 64 + lane; i < NFH * DM; i += NGW * 64) { const int n = i / DM, k = i % DM; F.WfT[i] = (bf16)f2bf(F.w_in[(size_t)k * INCOLS + NQKV + n] * F.g_attn[k]); }
    rows_to_bf16(F, F.x, F.bufA, F.rinv);
}
__device__ __forceinline__ void wd_convert(Frame& F, int first_wg) {
    const int tid = pg8::fresh_tid(F.wave), lane = tid & 63, wave = __builtin_amdgcn_readfirstlane(tid >> 6);
    LAS float* scr = (LAS float*)(F.lds + RING_OFF + wave * 16384);
    const int nw = (F.G - first_wg) * NWAVES, w0 = ((int)blockIdx.x - first_wg) * NWAVES + wave;
    constexpr int I_D = (DFF / 64) * (DM / 32);
    for (int r = w0; r < I_D; r += nw) { const int nblk = DM / 32, kb = r / nblk, nb = r % nblk; transpose_item<false>(F.w_down, DM, 64 * kb, 32 * nb, F.Wd_t, DFF, 32 * nb, scr, lane); }
}
__device__ __forceinline__ void flogit_phase(Frame& F) {
    LAS float* part = (LAS float*)(F.lds + RING_OFF);
    LAS float* ls = (LAS float*)(F.lds + RING_OFF + 4096);
    const int tid = pg8::fresh_tid(F.wave), lane = tid & 63, wave = __builtin_amdgcn_readfirstlane(tid >> 6);
    const int g = wave & 3, kh = wave >> 2, n = lane & 15, q = lane >> 4;
    for (int c = blockIdx.x; c < M / 64; c += F.G) {
        const int r0 = 64 * c;
        const bf16* hrow = F.bufA + (size_t)(r0 + 16 * g + n) * DM + kh * 2048 + 8 * q;
        const bf16* wrow = F.WfT + (size_t)n * DM + kh * 2048 + 8 * q;
        f32x4 acc = {0.f, 0.f, 0.f, 0.f};
#pragma unroll 8
        for (int s = 0; s < 64; ++s) { const bf16x8 a = *(const GAS bf16x8*)(hrow + 32 * s); const bf16x8 b = *(const GAS bf16x8*)(wrow + 32 * s);
            acc = __builtin_amdgcn_mfma_f32_16x16x32_bf16(a, b, acc, 0, 0, 0); }
        if (kh == 1) {
#pragma unroll
            for (int e = 0; e < 4; ++e) part[(16 * g + 4 * q + e) * 16 + n] = acc[e]; }
        __syncthreads();
        if (kh == 0) { const float bf = F.b_f[n];
#pragma unroll
            for (int e = 0; e < 4; ++e) { const float v = (acc[e] + part[(16 * g + 4 * q + e) * 16 + n]) * F.rinv[r0 + 16 * g + 4 * q + e] + bf;
                ls[(16 * g + 4 * q + e) * 16 + n] = fminf(v, 0.f) - log1pf(expf(-fabsf(v))); } }
        __syncthreads();
        if (wave == 0) {
            float v[16]; float run = 0.f;
#pragma unroll
            for (int j = 0; j < 16; ++j) { run += ls[(16 * q + j) * 16 + n]; v[j] = run; }
            const float t0 = __shfl(run, n), t1 = __shfl(run, n + 16), t2 = __shfl(run, n + 32);
            const float off = (q > 0 ? t0 : 0.f) + (q > 1 ? t1 : 0.f) + (q > 2 ? t2 : 0.f);
            const int b = r0 / SEQ, s0 = r0 % SEQ;
            float* dst = F.cumloc + (size_t)(b * NFH + n) * SEQ + s0 + 16 * q;
#pragma unroll
            for (int j = 0; j < 16; j += 4) *(GAS f32x4*)(dst + j) = (f32x4){v[j] + off, v[j + 1] + off, v[j + 2] + off, v[j + 3] + off};
            if (q == 3) F.ctot[(b * NFH + n) * 64 + (s0 >> 6)] = run + off;
        }
        __syncthreads();
    }
}
constexpr int D2_ITEMS = 32 * 16;
__device__ __forceinline__ att::Ref2 diff_ref(int L, int blk) {
    const int rr = L >> 8, w = L & 255, sigma = rr * 16 + (w & 7) * 2 + (w >> 7), pair = (w >> 3) & 15;
    const int qb = (blk >> 1) ? 31 - pair : pair, m = blk & 1;
    const int b = sigma >> 3, h = sigma & 7;
    att::Ref2 r; r.b = b; r.P0 = qb * 128; r.qcol = h * 2 + m; r.kcol = 16 + h * 2 + m; r.vcol = 32 + h * 2; r.head = h; r.m = m;
    return r;
}
constexpr int FOX_ITEMS = 64 * 8;
__device__ __forceinline__ att::BlockRef fox_ref(int L, int pass) {
    const int rr = L >> 8, w = L & 255, sigma = rr * 32 + (w & 7) * 4 + (w >> 6), pair = (w >> 3) & 7;
    const int qb = pass ? 15 - pair : pair;
    const int b = sigma >> 4, h = sigma & 15;
    att::BlockRef r; r.b = b; r.P0 = qb * 256; r.qcol = 48 + h; r.kcol = 64 + h; r.vcol = 80 + h; r.ocol = 2048 + h * 128; r.kind = 1; r.head = h;
    return r;
}
template <int ROLE> __device__ __forceinline__ void fox_run(Frame& F, char* lds) {
    int L = blockIdx.x;
    const int tid = pg8::fresh_tid(F.wave);
    const att::AttnBases AB{__builtin_amdgcn_make_buffer_rsrc((void*)F.bufB, 0, (int)((size_t)M * NQKV * 2), 0x00020000), F.od, F.mx, F.cumloc, F.ctot, F.relt, F.subg, 0.f};
    const int stride = F.G;
    int pass = 0;
    att::BlockRef cur = fox_ref(L, 0);
    att::Seam S;
    att::attn_prime(AB, cur, F.lds + RING_OFF, S, tid);
    for (;;) {
        const bool more_pass = pass == 0, more_item = L + stride < FOX_ITEMS, last = !more_pass && !more_item;
        int passn = pass + 1, Ln = L;
        if (!more_pass) { passn = 0; Ln = more_item ? L + stride : L; }
        const att::BlockRef nxt = last ? cur : fox_ref(Ln, passn);
        if (pass == 0) att::attn_tables(AB, fox_ref(L, 1), F.lds + RING_OFF, tid);
        att::attn_block<1, ROLE>(AB, cur, nxt, lds, F.lds + RING_OFF, S, tid);
        if (last) break;
        cur = nxt; pass = passn; L = Ln;
    }
}
__device__ __forceinline__ void fox_phase(Frame& F, char* lds) {
    if ((int)blockIdx.x >= FOX_ITEMS) return;
    if (F.wave < 4) fox_run<0>(F, lds); else fox_run<1>(F, lds);
}
__device__ __forceinline__ void diff_phase(Frame& F, char* lds) {
    const int tid = pg8::fresh_tid(F.wave);
    float lam;
    {   const int l = tid & 63;
        const float s1 = wave_sum(F.lq1[l] * F.lk1[l] + F.lq1[l + 64] * F.lk1[l + 64]), s2 = wave_sum(F.lq2[l] * F.lk2[l] + F.lq2[l + 64] * F.lk2[l + 64]);
        lam = __builtin_bit_cast(float, __builtin_amdgcn_readfirstlane(__builtin_bit_cast(int, expf(s1) - expf(s2) + 0.2f))); }
    const att::AttnBases AB{__builtin_amdgcn_make_buffer_rsrc((void*)F.bufB, 0, (int)((size_t)M * NQKV * 2), 0x00020000), F.od, F.mx, F.cumloc, F.ctot, F.relt, F.subg, lam};
    for (int L = blockIdx.x; L < D2_ITEMS; L += F.G) {
#pragma unroll 1
        for (int blk = 0; blk < 4; ++blk) att::diff_block(AB, diff_ref(L, blk), lds, F.lds + RING_OFF, tid);
    }
}
struct Args { const float* in[16]; float* out; unsigned char* ws; };
__global__ void __launch_bounds__(NWAVES * 64, 2) hybrid_fwd(Args args) {
    extern __shared__ __attribute__((aligned(16))) unsigned char lds[];
    Frame F;
    F.lds = (LAS unsigned char*)lds;
    F.MISC = (volatile LAS unsigned*)(F.lds + MISC_OFF);
    F.tid = threadIdx.x; F.lane = F.tid & 63; F.wave = __builtin_amdgcn_readfirstlane(F.tid >> 6);
    F.G = gridDim.x; { const int bx = blockIdx.x; F.vcu = (F.G % 8 == 0) ? (bx % 8) * (F.G / 8) + bx / 8 : bx; }
    unsigned char* ws = args.ws;
    F.ctl = (gu32*)(ws + WS_CTL);
    F.x = args.in[0]; F.g_attn = args.in[1]; F.w_in = args.in[2]; F.b_f = args.in[3]; F.lq1 = args.in[4]; F.lk1 = args.in[5]; F.lq2 = args.in[6]; F.lk2 = args.in[7];
    F.relt = args.in[8]; F.subg = args.in[9]; F.w_o = args.in[10]; F.g_ffn = args.in[11]; F.w_gate = args.in[12]; F.w_up = args.in[13]; F.w_down = args.in[14]; F.g_final = args.in[15];
    F.out = args.out;
    F.Win_t = (bf16*)(ws + WS_WIN); F.WfT = (bf16*)(ws + WS_WFT); F.Wo_t = (bf16*)(ws + WS_WO); F.Wgu_t = (bf16*)(ws + WS_WGU); F.Wd_t = (bf16*)(ws + WS_WD);
    F.bufA = (bf16*)(ws + WS_A); F.bufB = (bf16*)(ws + WS_B); F.od = (bf16*)args.out; F.xb = (bf16*)(ws + WS_XB);
    F.cumloc = (float*)(ws + WS_CUMLOC); F.ctot = (float*)(ws + WS_CTOT);
    F.mx = F.od + (size_t)M * DM; F.rinv = (float*)(F.ctl + CW_ROWSS + M);
    for (int u = F.tid; u < (LDS_BYTES - LDSCTL_OFF) / 4; u += NWAVES * 64) ((LAS unsigned*)(F.lds + LDSCTL_OFF))[u] = 0u;
    __syncthreads();
    XcdBarrier bar = xcd_barrier_post((unsigned*)(F.ctl + CW_BAR), F.MISC + 8);
#define GRID_BAR() xcd_barrier(bar)

    p0_prologue(F);
    GRID_BAR();
    flogit_phase(F);
    {   pg8::Gemm g{F.bufA, F.Win_t, M, NQKV, DM}; pg8::StaticOrder S; S.init(M, NQKV, F.G, (int)blockIdx.x);
        pg8::EpiQKVSlab E{F.bufB, SEQ, F.rinv};
        pg8::gemm_phase<pg8::EpiQKVSlab, pg8::StaticOrder, true, true>(F.lds + RING_OFF, g, S, E, F.wave); }
    GRID_BAR();
    fox_phase(F, (char*)lds + RING_OFF);
    __syncthreads();
    diff_phase(F, (char*)lds + RING_OFF);
    GRID_BAR();
    {   pg8::Gemm g{F.mx, F.Wo_t, M, DM, DM}; pg8::StaticOrder S; S.init(M, DM, F.G, (int)blockIdx.x);
        pg8::EpiResBToBf16Stats E{F.bufA, F.xb, DM, (float*)(F.ctl + CW_ROWSS)};
        pg8::gemm_phase<pg8::EpiResBToBf16Stats, pg8::StaticOrder, true, true>(F.lds + RING_OFF, g, S, E, F.wave); }
    GRID_BAR();
    {   pg8::Gemm g{F.xb, F.Wgu_t, M, NGU, DM}; pg8::StaticOrder S; S.init(M, NGU, F.G, (int)blockIdx.x);
        pg8::EpiSwiGLU E{F.bufB, DFF, (const float*)(F.ctl + CW_ROWSS), 1.0f / DM, EPS};
        pg8::gemm_phase<pg8::EpiSwiGLU, pg8::StaticOrder, true, true>(F.lds + RING_OFF, g, S, E, F.wave);
        const int rem = ((M / 256) * (NGU / 256)) % F.G;
        if ((int)blockIdx.x >= rem) wd_convert(F, rem); }
    GRID_BAR();
    {   pg8::Gemm g{F.bufB, F.Wd_t, M, DM, DFF}; pg8::StaticOrder S; S.init(M, DM, F.G, (int)blockIdx.x);
        pg8::EpiResBf16 E{F.xb, F.bufA, DM};
        pg8::gemm_phase<pg8::EpiResBf16, pg8::StaticOrder, true, true>(F.lds + RING_OFF, g, S, E, F.wave); }
    GRID_BAR();
    {   const bool bad = __hip_atomic_load(F.ctl + CW_BAR + XB_TMO, RLX_AGENT) != 0u || __hip_atomic_load(F.ctl + CW_TMO, RLX_AGENT) != 0u;
        norm_rows_bf16in(F, F.bufA, F.g_final, F.out, bad); }
#undef GRID_BAR
}

extern "C" void kernel_launch(void* const* d_in, const int* in_sizes, int n_in, void* d_out, int out_size, void* d_ws, size_t ws_size, hipStream_t stream) {
    static int grid = 0;
    if (grid == 0) {
        if (n_in != 16 || in_sizes[0] != M * DM || out_size != M * DM || ws_size < WS_END) { fprintf(stderr, "kernel_launch: shape/workspace mismatch (n_in %d, in0 %d, out %d, ws %zu); nothing launched\n", n_in, n_in > 0 ? in_sizes[0] : -1, out_size, ws_size); grid = -1; return; }
        int dev = 0, cus = 0, per_cu = 0;
        if (hipGetDevice(&dev) != hipSuccess || hipDeviceGetAttribute(&cus, hipDeviceAttributeMultiprocessorCount, dev) != hipSuccess) { fprintf(stderr, "kernel_launch: device query failed\n"); grid = -1; return; }
        if (hipFuncSetAttribute((const void*)hybrid_fwd, hipFuncAttributeMaxDynamicSharedMemorySize, LDS_BYTES) != hipSuccess) { fprintf(stderr, "kernel_launch: hipFuncSetAttribute failed\n"); grid = -1; return; }
        if (hipOccupancyMaxActiveBlocksPerMultiprocessor(&per_cu, (const void*)hybrid_fwd, NWAVES * 64, LDS_BYTES) != hipSuccess || per_cu < 1)
            fprintf(stderr, "kernel_launch: note: occupancy query reports %d workgroups per CU\n", per_cu);
        (void)hipGetLastError();
        grid = cus;
    }
    if (grid < 0) return;
    if (hipMemsetAsync((char*)d_ws + WS_CTL, 0, CTL_ZERO_BYTES, stream) != hipSuccess) { fprintf(stderr, "kernel_launch: hipMemsetAsync failed\n"); return; }
    Args a{};
    for (int i = 0; i < 16; ++i) a.in[i] = (const float*)d_in[i];
    a.out = (float*)d_out; a.ws = (unsigned char*)d_ws;
    hipLaunchKernelGGL(hybrid_fwd, dim3(grid), dim3(NWAVES * 64), LDS_BYTES, stream, a);
    const hipError_t le = hipPeekAtLastError();
    if (le != hipSuccess) fprintf(stderr, "kernel_launch: launch failed: %s\n", hipGetErrorName(le));
}
```

```cpp
#include <hip/hip_runtime.h>
#include <cstdio>
#include <cstdint>
#include <cmath>
namespace pg8 {
#define PG8_LAS __attribute__((address_space(3)))
typedef unsigned short bf16_t;
typedef short bf16x8 __attribute__((ext_vector_type(8)));
typedef float f32x4 __attribute__((ext_vector_type(4)));
typedef unsigned u32x4 __attribute__((ext_vector_type(4)));
constexpr int BM = 256, BK = 64, HALF = 128, HTB = HALF * BK * 2  , STAGE_BYTES = 8 * HTB, NXCD = 8, WGM = 8;

__host__ __device__ __forceinline__ int lds_byte(int r, int c) { const int st = (r >> 4) * 2 + (c >> 5), rr = r & 15, cc = c & 31, ob = rr * 64 + cc * 2; return st * 1024 + (ob ^ (((ob >> 9) & 1) << 5)); }
__host__ __device__ __forceinline__ void stage_rc(int b, int& R, int& C) { const int st = b / 1024, sb = b % 1024, swz = sb ^ (((sb >> 9) & 1) << 5); R = (st >> 1) * 16 + swz / 64; C = (st & 1) * 32 + (swz % 64) / 2; }
__host__ __device__ __forceinline__ int perm32(int rho) { const int n = rho >> 4, i = rho & 15; return 8 * (i >> 2) + 4 * n + (i & 3); }

struct Unit { int pm, pn; };
struct Gemm { const bf16_t* A; const bf16_t* Bt; int M, N, K; };

struct StaticOrder {
    int nM, nN, nwg, G, c;
    __host__ __device__ void init(int M, int N, int G_, int c_) { nM = M / BM; nN = N / BM; nwg = nM * nN; G = G_; c = c_; }
    __host__ __device__ bool next(int i, Unit& u) const {
        const long L = (long)i * G + c; if (L >= nwg) return false;
        int wgid = (int)L; { const int q = nwg / NXCD, r = nwg % NXCD, xcd = wgid % NXCD, off = wgid / NXCD; wgid = (xcd < r ? xcd * (q + 1) : r * (q + 1) + (xcd - r) * q) + off; }
        const int nig = WGM * nN, gid = wgid / nig, fm = gid * WGM, gsz = (nM - fm) < WGM ? (nM - fm) : WGM;
        u.pm = fm + ((wgid % nig) % gsz); u.pn = (wgid % nig) / gsz; return true;
    }
    __device__ __forceinline__ void a_ready(const Unit&) const {}
    __device__ __forceinline__ void done(const Unit&) const {}
};

__device__ __forceinline__ unsigned cvt_pk_bf16(float lo, float hi) { unsigned r; asm volatile("v_cvt_pk_bf16_f32 %0, %1, %2" : "=v"(r) : "v"(lo), "v"(hi)); return r; }
typedef float f32x2 __attribute__((ext_vector_type(2)));
__device__ __forceinline__ int fresh_lane() { int l; asm volatile("v_mbcnt_lo_u32_b32 %0, -1, 0\n\tv_mbcnt_hi_u32_b32 %0, -1, %0" : "=v"(l)); return l; }
__device__ __forceinline__ int fresh_tid(int wave) { return wave * 64 + fresh_lane(); }
struct EpiBf16Plain {
    static constexpr bool PERM = true, AFTER_DRAIN = false;
    bf16_t* O; int ldc;
    __device__ __forceinline__ void operator()(const f32x4 (&acc)[2][2][4][2], const Unit& u, int wr, int wc, int fr, int fq) const {
        const int row0 = u.pm * BM + wr * 64 + fr, col0 = u.pn * BM + wc * 32 + 8 * fq;
#pragma unroll
        for (int ai = 0; ai < 2; ++ai)
#pragma unroll
            for (int m = 0; m < 4; ++m) { bf16_t* rowp = O + (size_t)(row0 + ai * HALF + m * 16) * ldc + col0;
#pragma unroll
                for (int bj = 0; bj < 2; ++bj) { const f32x4 v0 = acc[ai][bj][m][0], v1 = acc[ai][bj][m][1];
                    u32x4 w; w.x = cvt_pk_bf16(v0[0], v0[1]); w.y = cvt_pk_bf16(v0[2], v0[3]); w.z = cvt_pk_bf16(v1[0], v1[1]); w.w = cvt_pk_bf16(v1[2], v1[3]);
                    *(u32x4*)(rowp + bj * HALF) = w; } }
    }
};
__device__ __forceinline__ float silu_mul(float g, float u) { return g * __builtin_amdgcn_rcpf(1.0f + __builtin_amdgcn_exp2f(g * -1.4426950408889634f)) * u; }
struct EpiSwiGLU {
    static constexpr bool PERM = true, AFTER_DRAIN = false;
    bf16_t* O; int ldc; const float* rowss; float inv_k, eps;
    __device__ __forceinline__ void operator()(const f32x4 (&acc)[2][2][4][2], const Unit& u, int wr, int wc, int fr, int fq) const {
        const int row0 = u.pm * BM + wr * 64 + fr, col0 = u.pn * HALF + wc * 32 + 8 * fq;
#pragma unroll
        for (int ai = 0; ai < 2; ++ai)
#pragma unroll
            for (int m = 0; m < 4; ++m) { const int row = row0 + ai * HALF + m * 16; bf16_t* rowp = O + (size_t)row * ldc + col0;
                const float rr = __builtin_amdgcn_rsqf(rowss[row] * inv_k + eps);
                const f32x4 g0 = acc[ai][0][m][0] * rr, g1 = acc[ai][0][m][1] * rr, u0 = acc[ai][1][m][0] * rr, u1 = acc[ai][1][m][1] * rr;
                u32x4 w; w.x = cvt_pk_bf16(silu_mul(g0[0], u0[0]), silu_mul(g0[1], u0[1])); w.y = cvt_pk_bf16(silu_mul(g0[2], u0[2]), silu_mul(g0[3], u0[3]));
                w.z = cvt_pk_bf16(silu_mul(g1[0], u1[0]), silu_mul(g1[1], u1[1])); w.w = cvt_pk_bf16(silu_mul(g1[2], u1[2]), silu_mul(g1[3], u1[3]));
                *(u32x4*)rowp = w; }
    }
};
template <bool STATS> struct EpiResF32 {
    static constexpr bool PERM = true, AFTER_DRAIN = false;
    const float* res; float* out; int ldc; bf16_t* xb; float* rowss;
    __device__ __forceinline__ void operator()(const f32x4 (&acc)[2][2][4][2], const Unit& u, int wr, int wc, int fr, int fq) const {
        const int row0 = u.pm * BM + wr * 64 + fr, col0 = u.pn * BM + wc * 32 + 8 * fq;
#pragma unroll
        for (int ai = 0; ai < 2; ++ai)
#pragma unroll
            for (int m = 0; m < 4; ++m) { const int row = row0 + ai * HALF + m * 16; const size_t off = (size_t)row * ldc + col0;
                f32x4 r[2][2];
#pragma unroll
                for (int bj = 0; bj < 2; ++bj)
#pragma unroll
                    for (int n = 0; n < 2; ++n) r[bj][n] = *(const f32x4*)(res + off + bj * HALF + n * 4);
                float ss = 0.f;
#pragma unroll
                for (int bj = 0; bj < 2; ++bj) {
#pragma unroll
                    for (int n = 0; n < 2; ++n) { r[bj][n] = r[bj][n] + acc[ai][bj][m][n]; *(f32x4*)(out + off + bj * HALF + n * 4) = r[bj][n];
                        if (STATS) ss += (r[bj][n][0] * r[bj][n][0] + r[bj][n][1] * r[bj][n][1]) + (r[bj][n][2] * r[bj][n][2] + r[bj][n][3] * r[bj][n][3]); }
                    if (STATS) { u32x4 w; w.x = cvt_pk_bf16(r[bj][0][0], r[bj][0][1]); w.y = cvt_pk_bf16(r[bj][0][2], r[bj][0][3]); w.z = cvt_pk_bf16(r[bj][1][0], r[bj][1][1]); w.w = cvt_pk_bf16(r[bj][1][2], r[bj][1][3]);
                        *(u32x4*)(xb + off + bj * HALF) = w; } }
                if (STATS) { ss += __shfl_xor(ss, 16); ss += __shfl_xor(ss, 32);
                    if (fq == 0) (void)__hip_atomic_fetch_add(rowss + row, ss, __ATOMIC_RELAXED, __HIP_MEMORY_SCOPE_AGENT); } }
    }
};

struct EpiResF32Plain {
    static constexpr bool PERM = false, AFTER_DRAIN = false;
    const float* res; float* out; int ldc;
    __device__ __forceinline__ void operator()(const f32x4 (&acc)[2][2][4][2], const Unit& u, int wr, int wc, int fr, int fq) const {
        const int row0 = u.pm * BM + wr * 64 + fr, col0 = u.pn * BM + wc * 32 + 4 * fq;
#pragma unroll
        for (int ai = 0; ai < 2; ++ai)
#pragma unroll
            for (int m = 0; m < 4; ++m) { const size_t off = (size_t)(row0 + ai * HALF + m * 16) * ldc + col0;
                f32x4 r[2][2];
#pragma unroll
                for (int bj = 0; bj < 2; ++bj)
#pragma unroll
                    for (int n = 0; n < 2; ++n) r[bj][n] = *(const f32x4*)(res + off + bj * HALF + n * 16);
#pragma unroll
                for (int bj = 0; bj < 2; ++bj)
#pragma unroll
                    for (int n = 0; n < 2; ++n) *(f32x4*)(out + off + bj * HALF + n * 16) = r[bj][n] + acc[ai][bj][m][n]; }
    }
};

struct EpiResToBf16Stats {
    static constexpr bool PERM = true, AFTER_DRAIN = false;
    const float* res; bf16_t* xb; int ldc; float* rowss;
    __device__ __forceinline__ void operator()(const f32x4 (&acc)[2][2][4][2], const Unit& u, int wr, int wc, int fr, int fq) const {
        const int row0 = u.pm * BM + wr * 64 + fr, col0 = u.pn * BM + wc * 32 + 8 * fq;
        f32x4 rA[2][2][2], rB[2][2][2];
#define EPI_LOAD(dst, q) do { _Pragma("unroll") for (int h_ = 0; h_ < 2; ++h_) { const int gi_ = 2 * (q) + h_; const size_t off_ = (size_t)(row0 + (gi_ >> 2) * HALF + (gi_ & 3) * 16) * ldc + col0;          \
            _Pragma("unroll") for (int bj = 0; bj < 2; ++bj) _Pragma("unroll") for (int n = 0; n < 2; ++n) dst[h_][bj][n] = *(const f32x4*)(res + off_ + bj * HALF + n * 4); } } while (0)
#define EPI_DONE(src, q) do { _Pragma("unroll") for (int h_ = 0; h_ < 2; ++h_) { const int gi_ = 2 * (q) + h_, ai = gi_ >> 2, m = gi_ & 3; const int row = row0 + ai * HALF + m * 16; const size_t off = (size_t)row * ldc + col0;   \
            float ss = 0.f;                                                                                                                                                              \
            _Pragma("unroll") for (int bj = 0; bj < 2; ++bj) { f32x4 v0 = src[h_][bj][0] + acc[ai][bj][m][0], v1 = src[h_][bj][1] + acc[ai][bj][m][1];                                     \
                ss += (v0[0] * v0[0] + v0[1] * v0[1]) + (v0[2] * v0[2] + v0[3] * v0[3]) + (v1[0] * v1[0] + v1[1] * v1[1]) + (v1[2] * v1[2] + v1[3] * v1[3]);                               \
                u32x4 w; w.x = cvt_pk_bf16(v0[0], v0[1]); w.y = cvt_pk_bf16(v0[2], v0[3]); w.z = cvt_pk_bf16(v1[0], v1[1]); w.w = cvt_pk_bf16(v1[2], v1[3]);                               \
                *(u32x4*)(xb + off + bj * HALF) = w; }                                                                                                                                     \
            ss += __shfl_xor(ss, 16); ss += __shfl_xor(ss, 32);                                                                                                                            \
            if (fq == 0) (void)__hip_atomic_fetch_add(rowss + row, ss, __ATOMIC_RELAXED, __HIP_MEMORY_SCOPE_AGENT); } } while (0)
        EPI_LOAD(rA, 0); EPI_LOAD(rB, 1);
        EPI_DONE(rA, 0); EPI_LOAD(rA, 2);
        EPI_DONE(rB, 1); EPI_LOAD(rB, 3);
        EPI_DONE(rA, 2);
        EPI_DONE(rB, 3);
#undef EPI_LOAD
#undef EPI_DONE
    }
};
struct EpiResBToBf16Stats {
    static constexpr bool PERM = true, AFTER_DRAIN = false;
    const bf16_t* resb; bf16_t* xb; int ldc; float* rowss;
    __device__ __forceinline__ void operator()(const f32x4 (&acc)[2][2][4][2], const Unit& u, int wr, int wc, int fr, int fq) const {
        const int row0 = u.pm * BM + wr * 64 + fr, col0 = u.pn * BM + wc * 32 + 8 * fq;
        u32x4 rA[2][2], rB[2][2];
#define EPI_LOAD(dst, q) do { _Pragma("unroll") for (int h_ = 0; h_ < 2; ++h_) { const int gi_ = 2 * (q) + h_; const size_t off_ = (size_t)(row0 + (gi_ >> 2) * HALF + (gi_ & 3) * 16) * ldc + col0;          \
            _Pragma("unroll") for (int bj = 0; bj < 2; ++bj) dst[h_][bj] = *(const u32x4*)(resb + off_ + bj * HALF); } } while (0)
#define EPI_DONE(src, q) do { _Pragma("unroll") for (int h_ = 0; h_ < 2; ++h_) { const int gi_ = 2 * (q) + h_, ai = gi_ >> 2, m = gi_ & 3; const int row = row0 + ai * HALF + m * 16; const size_t off = (size_t)row * ldc + col0;   \
            float ss = 0.f;                                                                                                                                                              \
            _Pragma("unroll") for (int bj = 0; bj < 2; ++bj) { const u32x4 hb = src[h_][bj];                                                                                              \
                const f32x4 x0 = {__uint_as_float(hb.x << 16), __uint_as_float(hb.x & 0xffff0000u), __uint_as_float(hb.y << 16), __uint_as_float(hb.y & 0xffff0000u)};                    \
                const f32x4 x1 = {__uint_as_float(hb.z << 16), __uint_as_float(hb.z & 0xffff0000u), __uint_as_float(hb.w << 16), __uint_as_float(hb.w & 0xffff0000u)};                    \
                const f32x4 v0 = x0 + acc[ai][bj][m][0], v1 = x1 + acc[ai][bj][m][1];                                                                                                     \
                ss += (v0[0] * v0[0] + v0[1] * v0[1]) + (v0[2] * v0[2] + v0[3] * v0[3]) + (v1[0] * v1[0] + v1[1] * v1[1]) + (v1[2] * v1[2] + v1[3] * v1[3]);                               \
                u32x4 w; w.x = cvt_pk_bf16(v0[0], v0[1]); w.y = cvt_pk_bf16(v0[2], v0[3]); w.z = cvt_pk_bf16(v1[0], v1[1]); w.w = cvt_pk_bf16(v1[2], v1[3]);                               \
                *(u32x4*)(xb + off + bj * HALF) = w; }                                                                                                                                     \
            ss += __shfl_xor(ss, 16); ss += __shfl_xor(ss, 32);                                                                                                                            \
            if (fq == 0) (void)__hip_atomic_fetch_add(rowss + row, ss, __ATOMIC_RELAXED, __HIP_MEMORY_SCOPE_AGENT); } } while (0)
        EPI_LOAD(rA, 0); EPI_LOAD(rB, 1);
        EPI_DONE(rA, 0); EPI_LOAD(rA, 2);
        EPI_DONE(rB, 1); EPI_LOAD(rB, 3);
        EPI_DONE(rA, 2);
        EPI_DONE(rB, 3);
#undef EPI_LOAD
#undef EPI_DONE
    }
};
struct EpiResBf16 {
    static constexpr bool PERM = true, AFTER_DRAIN = false;
    const bf16_t* res; bf16_t* out; int ldc;
    __device__ __forceinline__ void operator()(const f32x4 (&acc)[2][2][4][2], const Unit& u, int wr, int wc, int fr, int fq) const {
        const int row0 = u.pm * BM + wr * 64 + fr, col0 = u.pn * BM + wc * 32 + 8 * fq;
        u32x4 rb[2][4][2];
#pragma unroll
        for (int ai = 0; ai < 2; ++ai)
#pragma unroll
            for (int m = 0; m < 4; ++m)
#pragma unroll
                for (int bj = 0; bj < 2; ++bj) rb[ai][m][bj] = *(const u32x4*)(res + (size_t)(row0 + ai * HALF + m * 16) * ldc + col0 + bj * HALF);
#pragma unroll
        for (int ai = 0; ai < 2; ++ai)
#pragma unroll
            for (int m = 0; m < 4; ++m) { const size_t off = (size_t)(row0 + ai * HALF + m * 16) * ldc + col0;
#pragma unroll
                for (int bj = 0; bj < 2; ++bj) { const f32x4 a0 = acc[ai][bj][m][0], a1 = acc[ai][bj][m][1]; const u32x4 r = rb[ai][m][bj]; u32x4 w;
                    w.x = cvt_pk_bf16(__uint_as_float(r.x << 16) + a0[0], __uint_as_float(r.x & 0xffff0000u) + a0[1]);
                    w.y = cvt_pk_bf16(__uint_as_float(r.y << 16) + a0[2], __uint_as_float(r.y & 0xffff0000u) + a0[3]);
                    w.z = cvt_pk_bf16(__uint_as_float(r.z << 16) + a1[0], __uint_as_float(r.z & 0xffff0000u) + a1[1]);
                    w.w = cvt_pk_bf16(__uint_as_float(r.w << 16) + a1[2], __uint_as_float(r.w & 0xffff0000u) + a1[3]);
                    *(u32x4*)(out + off + bj * HALF) = w; } }
    }
};
struct EpiQKVSlab {
    static constexpr bool PERM = true, AFTER_DRAIN = false;
    bf16_t* O; int seq; const float* rinv;
    __device__ __forceinline__ void operator()(const f32x4 (&acc)[2][2][4][2], const Unit& u, int wr, int wc, int fr, int fq) const {
        const int row0 = u.pm * BM + wr * 64 + fr, b = row0 / seq, s0 = row0 - b * seq;
        float rs[2][4];
#pragma unroll
        for (int ai = 0; ai < 2; ++ai)
#pragma unroll
            for (int m = 0; m < 4; ++m) rs[ai][m] = rinv[row0 + ai * HALF + m * 16];
#pragma unroll
        for (int bj = 0; bj < 2; ++bj) { bf16_t* slab = O + ((size_t)(b * 96 + u.pn * 2 + bj) * seq + s0) * 128 + wc * 32 + 8 * fq;
#pragma unroll
            for (int ai = 0; ai < 2; ++ai)
#pragma unroll
                for (int m = 0; m < 4; ++m) { const f32x4 v0 = acc[ai][bj][m][0] * rs[ai][m], v1 = acc[ai][bj][m][1] * rs[ai][m];
                    u32x4 w; w.x = cvt_pk_bf16(v0[0], v0[1]); w.y = cvt_pk_bf16(v0[2], v0[3]); w.z = cvt_pk_bf16(v1[0], v1[1]); w.w = cvt_pk_bf16(v1[2], v1[3]);
                    *(u32x4*)(slab + (size_t)(ai * HALF + m * 16) * 128) = w; } }
    }
};
template <class Epi, class Sched, bool ALIGN_EPI = false, bool SP2 = false>
__device__ __forceinline__ void gemm_phase(PG8_LAS unsigned char* lds, const Gemm g, const Sched& S, const Epi& E, const int wave) {
    const int tid = fresh_tid(wave), wid = __builtin_amdgcn_readfirstlane(tid >> 6), lane = tid & 63, wr = wid >> 2, wc = wid & 3, fr = lane & 15, fq = lane >> 4;
    const int K = g.K, nt = K / BK;
    unsigned voffA[2], voffB[2];
#pragma unroll
    for (int i = 0; i < 2; ++i) { int R, C; stage_rc(tid * 16 + i * 8192, R, C); const int Rb = Epi::PERM ? ((R & ~31) + perm32(R & 31)) : R;
        voffA[i] = (unsigned)(R * K + C) * 2u; voffB[i] = (unsigned)(Rb * K + C) * 2u; }
    const size_t kstep = (size_t)(BK * 2);
    const size_t hstep = (size_t)HALF * K * 2;
    const size_t tstep = 2 * hstep;
    const unsigned ldsw = (unsigned)wid * 1024u;
    const int aoff = lds_byte(wr * 64 + fr, fq * 8), boff = lds_byte(wc * 32 + fr, fq * 8);
#define PG8_SA(b, h) (((b) * 2 + (h)) * HTB)
#define PG8_SB(b, h) ((4 + (b) * 2 + (h)) * HTB)
#define PG8_STAGE(bufoff, gbase, voff) do { _Pragma("unroll") for (int _i = 0; _i < 2; ++_i) \
        __builtin_amdgcn_global_load_lds((const unsigned*)((const char*)(gbase) + (voff)[_i]), (PG8_LAS unsigned*)(lds + (bufoff) + ldsw + _i * 8192), 16, 0, 0); } while (0)
#define PG8_LDA(dst, b, h) do { _Pragma("unroll") for (int m = 0; m < 4; ++m) _Pragma("unroll") for (int k = 0; k < 2; ++k) dst[m][k] = *(const PG8_LAS bf16x8*)(lds + PG8_SA(b, h) + aoff + m * 2048 + k * 1024); } while (0)
#define PG8_LDB(dst, b, h) do { _Pragma("unroll") for (int n = 0; n < 2; ++n) _Pragma("unroll") for (int k = 0; k < 2; ++k) dst[n][k] = *(const PG8_LAS bf16x8*)(lds + PG8_SB(b, h) + boff + n * 2048 + k * 1024); } while (0)
#define PG8_MMA(ai, bj, At, Bt) do { __builtin_amdgcn_s_setprio(1); _Pragma("unroll") for (int m = 0; m < 4; ++m) _Pragma("unroll") for (int n = 0; n < 2; ++n) _Pragma("unroll") for (int k = 0; k < 2; ++k) \
        acc[ai][bj][m][n] = __builtin_amdgcn_mfma_f32_16x16x32_bf16(Bt[n][k], At[m][k], acc[ai][bj][m][n], 0, 0, 0); __builtin_amdgcn_s_setprio(0); } while (0)
#define PG8_WAIT_V(n) asm volatile("s_waitcnt vmcnt(" #n ")" ::: "memory")
#define PG8_WAIT_L(n) asm volatile("s_waitcnt lgkmcnt(" #n ")" ::: "memory")
#define PG8_BAR __builtin_amdgcn_s_barrier()
#define PG8_SCHED __builtin_amdgcn_sched_barrier(0)
    Unit cur, nxt; int ui = 0;
    if (!S.next(0, cur)) return;
    f32x4 acc[2][2][4][2];
#pragma unroll
    for (int a = 0; a < 2; ++a)
#pragma unroll
        for (int b = 0; b < 2; ++b)
#pragma unroll
            for (int m = 0; m < 4; ++m)
#pragma unroll
                for (int n = 0; n < 2; ++n) acc[a][b][m][n] = (f32x4){0.f, 0.f, 0.f, 0.f};
    bf16x8 At[4][2], B0[2][2], B1[2][2];
    const char* cA = (const char*)g.A + (size_t)cur.pm * tstep; const char* cB = (const char*)g.Bt + (size_t)cur.pn * tstep;
    S.a_ready(cur);
    if constexpr (SP2) {
        PG8_STAGE(PG8_SB(0, 0), cB, voffB); PG8_STAGE(PG8_SB(0, 1), cB + hstep, voffB); PG8_STAGE(PG8_SA(0, 0), cA, voffA); PG8_STAGE(PG8_SA(0, 1), cA + hstep, voffA);
        if (wr == 1) PG8_BAR;
        PG8_WAIT_V(2); PG8_BAR;
        PG8_STAGE(PG8_SB(1, 0), cB + kstep, voffB); PG8_STAGE(PG8_SA(1, 0), cA + kstep, voffA); PG8_STAGE(PG8_SB(1, 1), cB + hstep + kstep, voffB);
        PG8_WAIT_V(6); PG8_BAR;
    } else {
        PG8_STAGE(PG8_SB(0, 0), cB, voffB); PG8_STAGE(PG8_SA(0, 0), cA, voffA); PG8_STAGE(PG8_SB(0, 1), cB + hstep, voffB); PG8_STAGE(PG8_SA(0, 1), cA + hstep, voffA);
        if (wr == 1) PG8_BAR;
        PG8_WAIT_V(4); PG8_BAR;
        PG8_STAGE(PG8_SB(1, 0), cB + kstep, voffB); PG8_STAGE(PG8_SA(1, 0), cA + kstep, voffA); PG8_STAGE(PG8_SB(1, 1), cB + hstep + kstep, voffB);
        PG8_WAIT_V(6); PG8_BAR;
    }
    for (;;) {
        const bool has_next = S.next(ui + 1, nxt);
        const char* nA = has_next ? (const char*)g.A + (size_t)nxt.pm * tstep : cA; const char* nB = has_next ? (const char*)g.Bt + (size_t)nxt.pn * tstep : cB;
        for (int t = 0; t < nt; t += 2) {
            const bool last = (t == nt - 2);
            const char* a1 = cA + (size_t)(t + 1) * kstep;
            const char* a2 = last ? nA : cA + (size_t)(t + 2) * kstep; const char* b2 = last ? nB : cB + (size_t)(t + 2) * kstep;
            const char* a3 = a2 + kstep; const char* b3 = b2 + kstep;
            if (last && has_next) S.a_ready(nxt);
            if constexpr (SP2) {
            PG8_LDB(B0, 0, 0); PG8_LDB(B1, 0, 1); PG8_SCHED; PG8_LDA(At, 0, 0); PG8_STAGE(PG8_SA(1, 1), a1 + hstep, voffA);
            PG8_WAIT_V(8); PG8_WAIT_L(0); PG8_BAR; PG8_MMA(0, 0, At, B0); PG8_MMA(0, 1, At, B1); PG8_BAR; PG8_SCHED;
            PG8_LDA(At, 0, 1); PG8_STAGE(PG8_SB(0, 0), b2, voffB); PG8_STAGE(PG8_SB(0, 1), b2 + hstep, voffB); PG8_STAGE(PG8_SA(0, 0), a2, voffA);
            PG8_WAIT_V(8); PG8_WAIT_L(0); PG8_BAR; PG8_MMA(1, 0, At, B0); PG8_MMA(1, 1, At, B1); PG8_BAR; PG8_SCHED;
            PG8_LDB(B0, 1, 0); PG8_LDB(B1, 1, 1); PG8_SCHED; PG8_LDA(At, 1, 0); PG8_STAGE(PG8_SA(0, 1), a2 + hstep, voffA);
            PG8_WAIT_V(8); PG8_WAIT_L(0); PG8_BAR; PG8_MMA(0, 0, At, B0); PG8_MMA(0, 1, At, B1); PG8_BAR; PG8_SCHED;
            PG8_LDA(At, 1, 1); PG8_STAGE(PG8_SB(1, 0), b3, voffB); PG8_STAGE(PG8_SB(1, 1), b3 + hstep, voffB); PG8_STAGE(PG8_SA(1, 0), a3, voffA);
            PG8_WAIT_V(8); PG8_WAIT_L(0); PG8_BAR; PG8_MMA(1, 0, At, B0); PG8_MMA(1, 1, At, B1); PG8_BAR; PG8_SCHED;
            } else {
            PG8_LDB(B0, 0, 0); PG8_SCHED; PG8_LDA(At, 0, 0); PG8_STAGE(PG8_SA(1, 1), a1 + hstep, voffA);
            PG8_WAIT_L(8); PG8_BAR; PG8_WAIT_L(0); PG8_MMA(0, 0, At, B0); PG8_BAR; PG8_SCHED;
            PG8_LDB(B1, 0, 1); PG8_STAGE(PG8_SB(0, 0), b2, voffB);
            PG8_BAR; PG8_WAIT_L(0); PG8_MMA(0, 1, At, B1); PG8_BAR;
            PG8_LDA(At, 0, 1); PG8_STAGE(PG8_SA(0, 0), a2, voffA);
            PG8_BAR; PG8_WAIT_L(0); PG8_MMA(1, 0, At, B0); PG8_BAR; PG8_SCHED;
            PG8_STAGE(PG8_SB(0, 1), b2 + hstep, voffB);
            PG8_WAIT_V(6); PG8_BAR; PG8_MMA(1, 1, At, B1); PG8_BAR;
            PG8_LDB(B0, 1, 0); PG8_SCHED; PG8_LDA(At, 1, 0); PG8_STAGE(PG8_SA(0, 1), a2 + hstep, voffA);
            PG8_WAIT_L(8); PG8_BAR; PG8_WAIT_L(0); PG8_MMA(0, 0, At, B0); PG8_BAR; PG8_SCHED;
            PG8_LDB(B1, 1, 1); PG8_STAGE(PG8_SB(1, 0), b3, voffB);
            PG8_BAR; PG8_WAIT_L(0); PG8_MMA(0, 1, At, B1); PG8_BAR;
            PG8_LDA(At, 1, 1); PG8_STAGE(PG8_SA(1, 0), a3, voffA);
            PG8_BAR; PG8_WAIT_L(0); PG8_MMA(1, 0, At, B0); PG8_BAR; PG8_SCHED;
            PG8_STAGE(PG8_SB(1, 1), b3 + hstep, voffB);
            PG8_WAIT_V(6); PG8_BAR; PG8_MMA(1, 1, At, B1); PG8_BAR;
            }
        }
        if constexpr (ALIGN_EPI) { if (wr == 0) PG8_BAR; }
        if constexpr (!Epi::AFTER_DRAIN) { E(acc, cur, wr, wc, fr, fq); S.done(cur); }
        if (!has_next) break;
#pragma unroll
        for (int a = 0; a < 2; ++a)
#pragma unroll
            for (int b = 0; b < 2; ++b)
#pragma unroll
                for (int m = 0; m < 4; ++m)
#pragma unroll
                    for (int n = 0; n < 2; ++n) acc[a][b][m][n] = (f32x4){0.f, 0.f, 0.f, 0.f};
        cur = nxt; cA = nA; cB = nB; ++ui;
        if constexpr (ALIGN_EPI) { if (wr == 1) PG8_BAR; }
    }
    PG8_WAIT_V(0);
    if constexpr (!ALIGN_EPI) { if (wr == 0) PG8_BAR; }
    PG8_BAR;
    if constexpr (Epi::AFTER_DRAIN) { E.fused(acc, cur, wr, wc, fr, fq, lds, wid, lane); S.done(cur); }
#undef PG8_SA
#undef PG8_SB
#undef PG8_STAGE
#undef PG8_LDA
#undef PG8_LDB
#undef PG8_MMA
#undef PG8_WAIT_V
#undef PG8_WAIT_L
#undef PG8_BAR
#undef PG8_SCHED
}
}
#ifndef BIASMODE
#define BIASMODE 3
#endif
namespace att {
typedef unsigned short bf16;
typedef short bf16x8 __attribute__((ext_vector_type(8)));
typedef short s16x4 __attribute__((ext_vector_type(4)));
typedef float f32x16 __attribute__((ext_vector_type(16)));
typedef float f32x4 __attribute__((ext_vector_type(4)));
typedef unsigned u32x4 __attribute__((ext_vector_type(4)));
#define ATT_LAS __attribute__((address_space(3)))
constexpr int D = 128, QPITCH = 128, NSLAB = 96, OPITCH = 4096, SKV = 4096, W = 4096;
constexpr float SCALE = 0.08838834764831845f;
constexpr float INV_SCALE = 11.313708498984761f;
constexpr float THR = 8.f;
constexpr int NW = 8, QBLK = 32, KVBLK = 64, QB = NW * QBLK;
constexpr int SHM_V = KVBLK * D * 2, SHM_K = KVBLK * D * 2;
constexpr int LDS_BODY = 2 * SHM_V + 2 * SHM_K + NW * 64 * 4;
constexpr int LDS_KB = 69632;
constexpr int LDS_REL = LDS_KB + 16384;
constexpr int LDS_PRE = LDS_REL + 2048;
constexpr int LDS_OST = LDS_PRE + 256, OST_ROW = 272, OST_WAVE = 16 * OST_ROW;
constexpr int LDS_BYTES_FOX = LDS_OST + NW * OST_WAVE;
constexpr int REL_N = 272, REL_TOP = 207;

#define KSWZ(row, colB) ((row) * 256 + ((colB) ^ (((row) & 7) << 4)))
#define SBAR() __builtin_amdgcn_sched_barrier(0)
__device__ __forceinline__ int v_st(int k, int c) { const int kk = (k & ~0xC) | ((k & 4) << 1) | ((k & 8) >> 1); return ((kk >> 3) * 4 + (c >> 5)) * 512 + ((kk & 7) * 32 + (c & 31)) * 2; }
__device__ __forceinline__ int v_rd_base(int lane) { return ((lane & 3) << 3) | (((lane >> 2) & 3) << 6) | (((lane >> 4) & 1) << 5) | (((lane >> 5) & 1) << 8); }
constexpr int v_rd_off(int d0, int ks, int half) { return d0 * 512 + ks * 4096 + half * 2048; }
__device__ __forceinline__ int crow(int r, int hi) { return (r & 3) + 8 * (r >> 2) + 4 * hi; }
__device__ __forceinline__ unsigned cvtpk(float lo, float hi) {
    unsigned r; asm volatile("v_cvt_pk_bf16_f32 %0, %1, %2" : "=v"(r) : "v"(lo), "v"(hi)); return r;
}
__device__ __forceinline__ bf16x8 load8(const bf16* p) { return *reinterpret_cast<const bf16x8*>(p); }
__device__ __forceinline__ bf16x8 bld8(__amdgpu_buffer_rsrc_t r, unsigned voff, unsigned soff) { return __builtin_bit_cast(bf16x8, __builtin_amdgcn_raw_buffer_load_b128(r, (int)voff, (int)soff, 0)); }
__device__ __forceinline__ void mask_tile(f32x16& p0, f32x16& p1, int dq) {
    const float NEG = -__builtin_inff();
#pragma unroll
    for (int r = 0; r < 16; ++r) {
        const int c = (r & 3) + 8 * (r >> 2);
        if (dq - c < 0) p0[r] = NEG;
        if (dq - c - 32 < 0) p1[r] = NEG;
    }
}
__device__ __forceinline__ void bias_key(f32x16& p0, f32x16& p1, const ATT_LAS float* kb) {
#pragma unroll
    for (int g = 0; g < 4; ++g) {
        const f32x4 a = *(const ATT_LAS f32x4*)(kb + 8 * g), b = *(const ATT_LAS f32x4*)(kb + 32 + 8 * g);
#pragma unroll
        for (int j = 0; j < 4; ++j) { p0[4 * g + j] += a[j]; p1[4 * g + j] += b[j]; }
    }
}
__device__ __forceinline__ void bias_rel(f32x16& p0, f32x16& p1, const ATT_LAS float* rp) {
#pragma unroll
    for (int r = 0; r < 16; ++r) {
        const int c = (r & 3) + 8 * (r >> 2);
        p0[r] += rp[c]; p1[r] += rp[c + 32];
    }
}
__device__ __forceinline__ void partialSM(f32x16& p0, f32x16& p1, float& m_reg, float& mn, float& alpha) {
    float pmax = p0[0]; for (int r = 1; r < 16; ++r) pmax = fmaxf(pmax, p0[r]); for (int r = 0; r < 16; ++r) pmax = fmaxf(pmax, p1[r]);
    { auto rr = __builtin_amdgcn_permlane32_swap(__float_as_uint(pmax), __float_as_uint(pmax), false, false);
      pmax = fmaxf(__uint_as_float(rr[0]), __uint_as_float(rr[1])); }
    constexpr float C2 = 1.4426950408889634f * SCALE;
    if (__builtin_expect(__all((pmax - m_reg) * SCALE <= THR), 1)) { mn = m_reg; alpha = 1.f; }
    else { mn = fmaxf(m_reg, pmax); alpha = __builtin_amdgcn_exp2f((m_reg - mn) * C2); m_reg = mn; }
    const float mnL = -mn * C2;
    for (int r = 0; r < 16; ++r) p0[r] = fmaf(p0[r], C2, mnL); for (int r = 0; r < 16; ++r) p1[r] = fmaf(p1[r], C2, mnL);
    for (int r = 0; r < 16; ++r) p0[r] = __builtin_amdgcn_exp2f(p0[r]);
}
__device__ __forceinline__ void finishSM(f32x16& p0, f32x16& p1, float alpha, float& l_reg, bf16x8& pa0, bf16x8& pa1, bf16x8& pa2, bf16x8& pa3) {
    for (int r = 0; r < 16; ++r) p1[r] = __builtin_amdgcn_exp2f(p1[r]);
    float ps = 0; for (int r = 0; r < 16; ++r) ps += p0[r]; for (int r = 0; r < 16; ++r) ps += p1[r];
    { auto rr = __builtin_amdgcn_permlane32_swap(__float_as_uint(ps), __float_as_uint(ps), false, false);
      ps = __uint_as_float(rr[0]) + __uint_as_float(rr[1]); }
    l_reg = l_reg * alpha + ps;
#define PK4(P, B_, OUT) do { unsigned a0 = cvtpk(P[B_+0], P[B_+1]), a1 = cvtpk(P[B_+2], P[B_+3]);                          \
        unsigned b0 = cvtpk(P[B_+4], P[B_+5]), b1 = cvtpk(P[B_+6], P[B_+7]);                                             \
        auto r0 = __builtin_amdgcn_permlane32_swap(a0, b0, false, false); auto r1 = __builtin_amdgcn_permlane32_swap(a1, b1, false, false); \
        u32x4 w = {r0[0], r1[0], r0[1], r1[1]}; OUT = *reinterpret_cast<bf16x8*>(&w); } while (0)
    PK4(p0, 0, pa0); PK4(p0, 8, pa1); PK4(p1, 0, pa2); PK4(p1, 8, pa3);
#undef PK4
}
template <int KB>
__device__ __forceinline__ void qkt(f32x16& p0, f32x16& p1, const char* K_lds, int r32, int hi, const bf16x8* qr) {
    p0 = f32x16{}; p1 = f32x16{};
    const char* kb[4];
#pragma unroll
    for (int dd = 0; dd < 4; ++dd) kb[dd] = K_lds + KB * SHM_K + KSWZ(r32, (dd * 16 + hi * 8) * 2);
#pragma unroll
    for (int d0 = 0; d0 < 8; ++d0) { const char* a = kb[d0 & 3] + (d0 >> 2) * 128;
        bf16x8 b0 = *reinterpret_cast<const bf16x8*>(a);
        bf16x8 b1 = *reinterpret_cast<const bf16x8*>(a + 32 * 256);
        p0 = __builtin_amdgcn_mfma_f32_32x32x16_bf16(b0, qr[d0], p0, 0, 0, 0);
        p1 = __builtin_amdgcn_mfma_f32_32x32x16_bf16(b1, qr[d0], p1, 0, 0, 0); }
}
template <int VB>
__device__ __forceinline__ void pv_tile(f32x16* o, int vb0, bf16x8 pa0, bf16x8 pa1, bf16x8 pa2, bf16x8 pa3) {
#define TRRD(dst, off) asm volatile("ds_read_b64_tr_b16 %0, %1 offset:%2" : "=&v"(dst) : "v"(vb0), "i"(off) : "memory")
#define PV_D0(d0) do { s16x4 l0, l1, l2, l3, h0, h1, h2, h3; constexpr int b_ = VB * SHM_V + v_rd_off(d0, 0, 0);     \
        TRRD(l0, b_); TRRD(h0, b_ + 2048); TRRD(l1, b_ + 4096); TRRD(h1, b_ + 6144); TRRD(l2, b_ + 8192); TRRD(h2, b_ + 10240); TRRD(l3, b_ + 12288); TRRD(h3, b_ + 14336); \
        asm volatile("s_waitcnt lgkmcnt(0)" ::: "memory"); SBAR();                                                           \
        o[d0] = __builtin_amdgcn_mfma_f32_32x32x16_bf16(pa0, (bf16x8){l0[0], l0[1], l0[2], l0[3], h0[0], h0[1], h0[2], h0[3]}, o[d0], 0, 0, 0);   \
        o[d0] = __builtin_amdgcn_mfma_f32_32x32x16_bf16(pa1, (bf16x8){l1[0], l1[1], l1[2], l1[3], h1[0], h1[1], h1[2], h1[3]}, o[d0], 0, 0, 0);   \
        o[d0] = __builtin_amdgcn_mfma_f32_32x32x16_bf16(pa2, (bf16x8){l2[0], l2[1], l2[2], l2[3], h2[0], h2[1], h2[2], h2[3]}, o[d0], 0, 0, 0);   \
        o[d0] = __builtin_amdgcn_mfma_f32_32x32x16_bf16(pa3, (bf16x8){l3[0], l3[1], l3[2], l3[3], h3[0], h3[1], h3[2], h3[3]}, o[d0], 0, 0, 0); } while (0)
    PV_D0(0); PV_D0(1); PV_D0(2); PV_D0(3);
#undef PV_D0
#undef TRRD
}

struct BlockRef { int b, P0, qcol, kcol, vcol, ocol, kind, head; };
struct AttnBases { __amdgpu_buffer_rsrc_t prs; bf16* od; bf16* mixed; const float* cumloc; const float* ctot; const float* relt; const float* subg; float lam; };
#define BR_Q(r) ((((unsigned)((r).b * NSLAB + (r).qcol)) << 20) + (unsigned)(r).P0 * 256u)
#define BR_K(r) (((unsigned)((r).b * NSLAB + (r).kcol)) << 20)
#define BR_V(r) (((unsigned)((r).b * NSLAB + (r).vcol)) << 20)
#define BR_O(r) (((r).kind ? AB.mixed : AB.od) + ((size_t)(r).b * SKV + (r).P0) * OPITCH + (r).ocol)
#define BR_CL(r) (AB.cumloc + (size_t)((r).b * 16 + (r).head) * SKV)
#define BR_CT(r) (AB.ctot + ((r).b * 16 + (r).head) * 64)
struct Seam { bf16x8 qr[8]; };
#define VMW() asm volatile("s_waitcnt vmcnt(0)" ::: "memory")
#define FDMA(ldsoff, voffX, src) do { _Pragma("unroll") for (int j_ = 0; j_ < 2; ++j_)                                          \
        __builtin_amdgcn_raw_ptr_buffer_load_lds(AB.prs, (ATT_LAS void*)(ldsL + (ldsoff) + wid * 1024 + j_ * 8192), 16, (int)(voffX), (int)((src) + j_ * 8192), 0, 0); } while (0)
#define FDMA_K(src, bf) FDMA(2 * SHM_V + (bf) * SHM_K, voffK, src)
#define FDMA_V(src, bf) FDMA((bf) * SHM_V, voffV, src)
#define FDMA_OFFS(ln) const unsigned voffK = (unsigned)((4 * wid + ((ln) >> 4)) * 256 + ((((ln) & 15) ^ (4 * (wid & 1) + ((ln) >> 4))) * 16)),                                   \
                     voffV = (unsigned)(((((wid >> 2) * 16 + (((ln) >> 4) & 1) * 8 + ((wid >> 1) & 1) * 4 + (((ln) >> 2) & 3)) * 256) + ((((wid & 1) * 2 + ((ln) >> 5)) * 32 + ((ln) & 3) * 8) * 2)))
__device__ __forceinline__ void attn_prime(const AttnBases& AB, const BlockRef& cur, ATT_LAS unsigned char* ldsL, Seam& S, const int tid) {
    const int wid = __builtin_amdgcn_readfirstlane(tid >> 6), lane = tid & 63, r32 = lane & 31, hi = lane >> 5;
    FDMA_OFFS(lane);
    const unsigned voff_q = (unsigned)((wid * QBLK + r32) * QPITCH + hi * 8) * 2u;
    for (int d0 = 0; d0 < 8; ++d0) S.qr[d0] = bld8(AB.prs, voff_q, BR_Q(cur) + d0 * 32);
    FDMA_K(BR_K(cur), 0); FDMA_K(BR_K(cur) + (unsigned)KVBLK * 256u, 1); FDMA_V(BR_V(cur), 0); VMW();
    __syncthreads();
}
__device__ __forceinline__ void attn_tables(const AttnBases& AB, const BlockRef& cur, ATT_LAS unsigned char* ldsL, const int tid) {
    const float* relt = AB.relt; const float* cl = BR_CL(cur); const float* ct = BR_CT(cur);
    const int lane = tid & 63;
    ATT_LAS float* pre = (ATT_LAS float*)(ldsL + LDS_PRE);
    if (cur.kind == 1) {
        if (tid < 64) { const float v = ct[lane]; float s = v;
#pragma unroll
            for (int o = 1; o < 64; o <<= 1) { const float t = __shfl_up(s, o); if (lane >= o) s += t; }
            pre[lane] = s - v; }
    } else {
        if (tid < REL_N) { const int dist = REL_TOP - tid; float val = 0.f;
            if (dist >= 0) { int bk = dist;
                if (dist >= 16) { const float nf = (float)dist; int lg = 16 + (int)(logf(nf / 16.0f) / 2.0794415416798357f * 16.0f); bk = lg < 31 ? lg : 31; }
                val = (relt[bk * 8 + cur.head] - relt[31 * 8 + cur.head]) * INV_SCALE; }
            ((ATT_LAS float*)(ldsL + LDS_REL))[tid] = val; }
    }
    __syncthreads();
    if (cur.kind == 1) {
        const int k8 = tid * 8;
        if (k8 < cur.P0 + QB) {
            const float cref = pre[cur.P0 >> 6] + cl[cur.P0];
            const float pc = pre[k8 >> 6];
            const f32x4 a = *(const f32x4*)(cl + k8), b = *(const f32x4*)(cl + k8 + 4);
            ATT_LAS f32x4* dst = (ATT_LAS f32x4*)(ldsL + LDS_KB) + tid * 2;
            f32x4 o0, o1;
#pragma unroll
            for (int j = 0; j < 4; ++j) { o0[j] = (cref - (pc + a[j])) * INV_SCALE; o1[j] = (cref - (pc + b[j])) * INV_SCALE; }
            dst[0] = o0; dst[1] = o1;
        }
    }
    __syncthreads();
}
template <int BIASM, int ROLE> __device__ __forceinline__ void attn_block(const AttnBases& AB, const BlockRef& cur, const BlockRef& nxt, char* lds, ATT_LAS unsigned char* ldsL, Seam& S, const int tid) {
    const int wid = __builtin_amdgcn_readfirstlane(tid >> 6), lane = tid & 63, r32 = lane & 31, hi = lane >> 5;
    const int NT = 4 * ((cur.P0 >> 8) + 1);
    const int qlo = cur.P0 + wid * QBLK, qm = qlo + r32 - 4 * hi;
    char* V_lds = lds; char* K_lds = lds + 2 * SHM_V;
    float* ws = (float*)(lds + 2 * SHM_V + 2 * SHM_K) + wid * 64; float* li_l = ws, * al_l = ws + 32;
    float m_reg = -1e30f, l_reg = 0; f32x16 o[4] = {};
    const int vb0 = (int)(uintptr_t)V_lds + v_rd_base(lane);
    const unsigned voff_q = (unsigned)((wid * QBLK + r32) * QPITCH + hi * 8) * 2u;
    FDMA_OFFS(lane);
    const unsigned Kh = BR_K(cur), Vh = BR_V(cur);
    const int kind = cur.kind;
    const ATT_LAS float* kbL = (const ATT_LAS float*)(ldsL + LDS_KB) + 4 * hi;
    const ATT_LAS float* rlL = (const ATT_LAS float*)(ldsL + LDS_REL) + (REL_TOP - qm);
#define RESC(a) do { if (__any((a) < 1.f)) { if (hi == 0) al_l[r32] = (a); asm volatile("s_waitcnt lgkmcnt(0)" ::: "memory");              \
                     for (int d_ = 0; d_ < 4; ++d_) for (int r = 0; r < 16; ++r) o[d_][r] *= al_l[crow(r, hi)]; } } while (0)
#define KBASE(t) ((t) * KVBLK)
#define MASKT(P0_, P1_, t) do { const int kb_ = KBASE(t);                                                                      \
        if (BIASM & 1) { if (kind == 1) bias_key(P0_, P1_, kbL + kb_); }                                                      \
        if (BIASM & 2) { if (kind != 1 && kb_ > qlo - 176 && kb_ <= qlo) bias_rel(P0_, P1_, rlL + kb_); }                         \
        if (kb_ + KVBLK - 1 > qlo) mask_tile(P0_, P1_, qm - kb_); } while (0)
    f32x16 p0, p1; float mn, al; bf16x8 pa0, pa1, pa2, pa3;
#define STEP_DMA(s, SB) do { SBAR(); if ((s) + 2 < NT) FDMA_K(Kh + (unsigned)KBASE((s) + 2) * 256u, SB); FDMA_V(Vh + (unsigned)KBASE((s) + 1) * 256u, 1 - (SB)); SBAR(); } while (0)
#define LAST_DMA() do { SBAR(); FDMA_V(BR_V(nxt), 0); FDMA_K(BR_K(nxt), 0); FDMA_K(BR_K(nxt) + (unsigned)KVBLK * 256u, 1); SBAR();                \
        _Pragma("unroll") for (int d0 = 0; d0 < 8; ++d0) S.qr[d0] = bld8(AB.prs, voff_q, BR_Q(nxt) + d0 * 32); SBAR(); } while (0)
#define LV(t) (KBASE(t) <= qlo + QBLK - 1)
#define SOFTMAX(t) do { MASKT(p0, p1, (t)); partialSM(p0, p1, m_reg, mn, al); finishSM(p0, p1, al, l_reg, pa0, pa1, pa2, pa3); RESC(al); SBAR(); } while (0)
    if (ROLE == 0) {
        qkt<0>(p0, p1, K_lds, r32, hi, S.qr);
        __syncthreads();
#define STEP0(s, SB) do { STEP_DMA(s, SB); SOFTMAX(s);                                                                         \
            qkt<1 - (SB)>(p0, p1, K_lds, r32, hi, S.qr); SBAR(); pv_tile<SB>(o, vb0, pa0, pa1, pa2, pa3);                     \
            VMW(); __syncthreads(); } while (0)
#define STEP0C(s, SB) do { STEP_DMA(s, SB); if (LV(s)) SOFTMAX(s);                                                             \
            if (LV((s) + 1)) qkt<1 - (SB)>(p0, p1, K_lds, r32, hi, S.qr);                                                     \
            SBAR(); if (LV(s)) pv_tile<SB>(o, vb0, pa0, pa1, pa2, pa3);                                                       \
            VMW(); __syncthreads(); } while (0)
        for (int s = 0; s + 4 < NT; s += 2) { STEP0(s, 0); STEP0(s + 1, 1); }
        STEP0C(NT - 4, 0); STEP0C(NT - 3, 1); STEP0C(NT - 2, 0);
        LAST_DMA();
        if (LV(NT - 1)) { SOFTMAX(NT - 1);
            pv_tile<1>(o, vb0, pa0, pa1, pa2, pa3); }
#undef STEP0
#undef STEP0C
    } else {
        qkt<0>(p0, p1, K_lds, r32, hi, S.qr);
        SOFTMAX(0);
        __syncthreads();
#define STEP1(s, SB) do { STEP_DMA(s, SB);                                                                                     \
            qkt<1 - (SB)>(p0, p1, K_lds, r32, hi, S.qr); SBAR(); pv_tile<SB>(o, vb0, pa0, pa1, pa2, pa3);                     \
            SOFTMAX((s) + 1);                                                                                                 \
            VMW(); __syncthreads(); } while (0)
#define STEP1C(s, SB) do { STEP_DMA(s, SB);                                                                                    \
            if (LV((s) + 1)) qkt<1 - (SB)>(p0, p1, K_lds, r32, hi, S.qr);                                                     \
            SBAR(); if (LV(s)) pv_tile<SB>(o, vb0, pa0, pa1, pa2, pa3);                                                       \
            if (LV((s) + 1)) SOFTMAX((s) + 1);                                                                                \
            VMW(); __syncthreads(); } while (0)
        for (int s = 0; s + 4 < NT; s += 2) { STEP1(s, 0); STEP1(s + 1, 1); }
        STEP1C(NT - 4, 0); STEP1C(NT - 3, 1); STEP1C(NT - 2, 0);
        LAST_DMA();
        if (LV(NT - 1)) pv_tile<1>(o, vb0, pa0, pa1, pa2, pa3);
#undef STEP1
#undef STEP1C
    }
    SBAR();
#undef STEP_DMA
#undef LAST_DMA
#undef SOFTMAX
#undef LV
    if (hi == 0) li_l[r32] = l_reg; asm volatile("s_waitcnt lgkmcnt(0)" ::: "memory");
    float rli[16];
#pragma unroll
    for (int r = 0; r < 16; ++r) rli[r] = __builtin_amdgcn_rcpf(li_l[crow(r, hi)]);
    bf16* Ow = BR_O(cur) + (size_t)(wid * QBLK) * OPITCH;
    ATT_LAS unsigned char* ost = ldsL + LDS_OST + wid * OST_WAVE;
    int ln = lane; asm volatile("" : "+v"(ln));
    const int wr_off = (4 * (ln >> 5)) * OST_ROW + (ln & 31) * 2, rd_off = (ln >> 4) * OST_ROW + (ln & 15) * 16;
    const unsigned voff_o = (unsigned)((ln >> 4) * OPITCH + (ln & 15) * 8);
#pragma unroll
    for (int p = 0; p < 2; ++p) {
#pragma unroll
        for (int rr = 0; rr < 8; ++rr) { const int r = 8 * p + rr, row0 = (rr & 3) + 8 * (rr >> 2);
#pragma unroll
            for (int d0 = 0; d0 < 4; d0 += 2) { const unsigned w = cvtpk(o[d0][r] * rli[r], o[d0 + 1][r] * rli[r]);
                *(ATT_LAS unsigned short*)(ost + wr_off + row0 * OST_ROW + d0 * 64) = (unsigned short)(w & 0xffffu);
                *(ATT_LAS unsigned short*)(ost + wr_off + row0 * OST_ROW + (d0 + 1) * 64) = (unsigned short)(w >> 16); } }
        asm volatile("s_waitcnt lgkmcnt(0)" ::: "memory");
        u32x4 ch[4];
#pragma unroll
        for (int j = 0; j < 4; ++j) ch[j] = *(const ATT_LAS u32x4*)(ost + rd_off + (4 * j) * OST_ROW);
        asm volatile("s_waitcnt lgkmcnt(0)" ::: "memory");
#pragma unroll
        for (int j = 0; j < 4; ++j) *(u32x4*)(Ow + (size_t)(16 * p + 4 * j) * OPITCH + voff_o) = ch[j];
    }
    VMW(); __syncthreads();
#undef RESC
#undef KBASE
#undef MASKT
}
constexpr int D2_K = 0, D2_VA = 32768, D2_VB = 65536, D2_P = 98304, D2_PSLOT = 4352, D2_LI = D2_P + 8 * D2_PSLOT, D2_WS = D2_LI + 512, D2_REL = D2_WS + 1024, D2_SS = D2_REL + 2048  , D2_BYTES = D2_SS + 1024;
constexpr int D2_QB = 128;
struct Ref2 { int b, P0, qcol, kcol, vcol, head, m; };
__device__ __forceinline__ void diff_block(const AttnBases& AB, const Ref2& R, char* lds, ATT_LAS unsigned char* ldsL, const int tid) {
    const int wid = __builtin_amdgcn_readfirstlane(tid >> 6), lane = tid & 63, r32 = lane & 31, hi = lane >> 5;
    const bool isA = wid < 4; const int g = wid & 3;
    const int NT = 2 * ((R.P0 >> 7) + 1);
    const unsigned Qb = (((unsigned)(R.b * NSLAB + R.qcol)) << 20) + (unsigned)R.P0 * 256u;
    const unsigned Kh = ((unsigned)(R.b * NSLAB + R.kcol)) << 20;
    const unsigned Vh = ((unsigned)(R.b * NSLAB + R.vcol)) << 20;
    const int qlo = R.P0 + g * QBLK, qm = qlo + r32 - 4 * hi;
    char* K_lds = lds + D2_K;
    const int vbA = (int)(uintptr_t)(lds + D2_VA) + v_rd_base(lane), vbB = (int)(uintptr_t)(lds + D2_VB) + v_rd_base(lane);
    ATT_LAS float* al_l = (ATT_LAS float*)(ldsL + D2_WS) + g * 64;
    ATT_LAS float* liS = (ATT_LAS float*)(ldsL + D2_LI) + g * 32;
    const ATT_LAS float* rlL = (const ATT_LAS float*)(ldsL + D2_REL) + (REL_TOP - qm);
    const int wb = wid & 3;
    f32x16 o[4] = {};
#define D2_BAR() do { asm volatile("s_waitcnt lgkmcnt(0)" ::: "memory"); __builtin_amdgcn_s_barrier(); asm volatile("" ::: "memory"); } while (0)
#define VMW() asm volatile("s_waitcnt vmcnt(0)" ::: "memory")
#define KBASE(t) ((t) * KVBLK)
#define PSLOT(buf) (ldsL + D2_P + (g * 2 + (buf)) * D2_PSLOT)
#define DMA_TILE(ldsoff, voffX, src) do { _Pragma("unroll") for (int j_ = 0; j_ < 4; ++j_)                                    \
        __builtin_amdgcn_raw_ptr_buffer_load_lds(AB.prs, (ATT_LAS void*)(ldsL + (ldsoff) + wb * 1024 + j_ * 4096), 16, (int)(voffX), (int)((src) + j_ * 4096), 0, 0); } while (0)
#define DMA_K(t, bf)  DMA_TILE(D2_K + (bf) * SHM_K, voffK, Kh + (unsigned)KBASE(t) * 256u)
#define DMA_VA(t, bf) DMA_TILE(D2_VA + (bf) * SHM_V, voffV, Vh + (unsigned)KBASE(t) * 256u)
#define DMA_VB(t, bf) DMA_TILE(D2_VB + (bf) * SHM_V, voffV, Vh + (1u << 20) + (unsigned)KBASE(t) * 256u)
#define RESC(a) do { if (__any((a) < 1.f)) { if (hi == 0) al_l[r32] = (a); asm volatile("s_waitcnt lgkmcnt(0)" ::: "memory");              \
                     for (int d_ = 0; d_ < 4; ++d_) for (int r = 0; r < 16; ++r) o[d_][r] *= al_l[crow(r, hi)]; } } while (0)
#define MASKT(P0_, P1_, t) do { const int kb_ = KBASE(t);                                                                      \
        if (kb_ > qlo - 176 && kb_ <= qlo) bias_rel(P0_, P1_, rlL + kb_);                                                      \
        if (kb_ + KVBLK - 1 > qlo) mask_tile(P0_, P1_, qm - kb_); } while (0)
#define P_PUT(buf, alY) do { ATT_LAS unsigned char* s_ = PSLOT(buf);                                                            \
        *(ATT_LAS bf16x8*)(s_ + lane * 16) = pa0; *(ATT_LAS bf16x8*)(s_ + 1024 + lane * 16) = pa1;                            \
        *(ATT_LAS bf16x8*)(s_ + 2048 + lane * 16) = pa2; *(ATT_LAS bf16x8*)(s_ + 3072 + lane * 16) = pa3;                     \
        if (hi == 0) *(ATT_LAS float*)(s_ + 4096 + r32 * 4) = (alY);                                                          \
        const int any_ = __any((alY) < 1.f) ? 1 : 0; if (lane == 0) *(ATT_LAS int*)(s_ + 4224) = any_; } while (0)
#define P_GET_PV(buf) do { const ATT_LAS unsigned char* s_ = PSLOT(buf);                                                       \
        pa0 = *(const ATT_LAS bf16x8*)(s_ + lane * 16); pa1 = *(const ATT_LAS bf16x8*)(s_ + 1024 + lane * 16);               \
        pa2 = *(const ATT_LAS bf16x8*)(s_ + 2048 + lane * 16); pa3 = *(const ATT_LAS bf16x8*)(s_ + 3072 + lane * 16);        \
        const int any_ = __builtin_amdgcn_readfirstlane(*(const ATT_LAS int*)(s_ + 4224));                                    \
        if (any_) { _Pragma("unroll") for (int gq = 0; gq < 4; ++gq) { const f32x4 a_ = *(const ATT_LAS f32x4*)(s_ + 4096 + (8 * gq + 4 * hi) * 4);       \
                _Pragma("unroll") for (int d_ = 0; d_ < 4; ++d_) _Pragma("unroll") for (int j_ = 0; j_ < 4; ++j_) o[d_][4 * gq + j_] *= a_[j_]; } }     \
        asm volatile("s_waitcnt lgkmcnt(0)" ::: "memory"); SBAR();                                                            \
        pv_tile<buf>(o, vbB, pa0, pa1, pa2, pa3); } while (0)
    if (tid < REL_N) { const int dist = REL_TOP - tid; float val = 0.f;
        if (dist >= 0) { int bk = dist;
            if (dist >= 16) { const float nf = (float)dist; int lg = 16 + (int)(logf(nf / 16.0f) / 2.0794415416798357f * 16.0f); bk = lg < 31 ? lg : 31; }
            val = (AB.relt[bk * 8 + R.head] - AB.relt[31 * 8 + R.head]) * INV_SCALE; }
        ((ATT_LAS float*)(ldsL + D2_REL))[tid] = val; }
    if (isA) {
        float m_reg = -1e30f, l_reg = 0.f; bf16x8 qr[8];
        f32x16 pA0, pA1, pB0, pB1; float mnA, mnB, alA = 1.f, alB = 1.f; bf16x8 pa0, pa1, pa2, pa3;
#pragma unroll
        for (int d0 = 0; d0 < 8; ++d0) qr[d0] = bld8(AB.prs, (unsigned)((g * QBLK + r32) * QPITCH + hi * 8) * 2u, Qb + d0 * 32);
        D2_BAR();
        SBAR(); qkt<0>(pA0, pA1, K_lds, r32, hi, qr); MASKT(pA0, pA1, 0); partialSM(pA0, pA1, m_reg, mnA, alA);
        D2_BAR();
#define STEP_A(PX0, PX1, mnX, alX, PY0, PY1, alY, t, KB, PVB) do {                                                             \
            SBAR(); qkt<KB>(PX0, PX1, K_lds, r32, hi, qr);                                                                    \
            finishSM(PY0, PY1, alY, l_reg, pa0, pa1, pa2, pa3); SBAR();                                                       \
            P_PUT(PVB, alY);                                                                                                  \
            pv_tile<PVB>(o, vbA, pa0, pa1, pa2, pa3); MASKT(PX0, PX1, (t)); partialSM(PX0, PX1, m_reg, mnX, alX);             \
            RESC(alX); D2_BAR(); } while (0)
        for (int t = 1; t + 1 < NT; t += 2) {
            STEP_A(pB0, pB1, mnB, alB, pA0, pA1, alA, t, 1, 0);
            STEP_A(pA0, pA1, mnA, alA, pB0, pB1, alB, t + 1, 0, 1);
        }
        const bool lvL = KBASE(NT - 1) <= qlo + QBLK - 1;
        SBAR(); if (lvL) qkt<1>(pB0, pB1, K_lds, r32, hi, qr);
        finishSM(pA0, pA1, alA, l_reg, pa0, pa1, pa2, pa3); SBAR();
        P_PUT(0, alA);
        pv_tile<0>(o, vbA, pa0, pa1, pa2, pa3);
        if (lvL) { MASKT(pB0, pB1, NT - 1); partialSM(pB0, pB1, m_reg, mnB, alB); RESC(alB); }
        D2_BAR();
        if (lvL) { finishSM(pB0, pB1, alB, l_reg, pa0, pa1, pa2, pa3); SBAR(); P_PUT(1, alB); pv_tile<1>(o, vbA, pa0, pa1, pa2, pa3); }
        if (hi == 0) liS[r32] = l_reg;
        D2_BAR();
#undef STEP_A
    } else {
        bf16x8 pa0, pa1, pa2, pa3;
        int lb = lane; asm volatile("" : "+v"(lb));
        const unsigned voffK = (unsigned)((4 * wb + (lb >> 4)) * 256 + (((lb & 15) ^ (4 * (wb & 1) + (lb >> 4))) * 16));
        const unsigned voffV = (unsigned)(((((lb >> 4) & 1) * 8 + ((wb >> 1) & 1) * 4 + ((lb >> 2) & 3)) * 256) + ((((wb & 1) * 2 + (lb >> 5)) * 32 + (lb & 3) * 8) * 2));
        DMA_K(0, 0); VMW();
        D2_BAR();
        DMA_K(1, 1); DMA_VA(0, 0); VMW();
        D2_BAR();
#define STEP_B(t, KB, PVB) do {                                                                                                \
            if ((t) + 1 < NT) DMA_K((t) + 1, PVB); DMA_VA(t, KB); DMA_VB((t) - 1, PVB); SBAR();                               \
            if ((t) >= 2) P_GET_PV(KB);                                                                                       \
            VMW(); D2_BAR(); } while (0)
        for (int t = 1; t + 1 < NT; t += 2) { STEP_B(t, 1, 0); STEP_B(t + 1, 0, 1); }
        STEP_B(NT - 1, 1, 0);
        DMA_VB(NT - 1, 1);
        P_GET_PV(0);
        VMW(); D2_BAR();
        if (KBASE(NT - 1) <= qlo + QBLK - 1) P_GET_PV(1);
#undef STEP_B
    }
    {   float rli[16];
#pragma unroll
        for (int r = 0; r < 16; ++r) rli[r] = __builtin_amdgcn_rcpf(liS[crow(r, hi)]);
        const int hfw = isA ? 0 : 1;
        bf16* O1w = AB.od + ((size_t)R.b * SKV + R.P0 + g * QBLK) * OPITCH + R.head * 512 + hfw * 128;
        bf16* Mw = AB.mixed + ((size_t)R.b * SKV + R.P0 + g * QBLK) * OPITCH + R.head * 256 + hfw * 128;
        ATT_LAS unsigned char* ost = ldsL + (isA ? D2_K : D2_VA) + g * OST_WAVE;
        int ln = lane; asm volatile("" : "+v"(ln));
        const int wr_off = (4 * (ln >> 5)) * OST_ROW + (ln & 31) * 2, rd_off = (ln >> 4) * OST_ROW + (ln & 15) * 16;
        const unsigned voff_o = (unsigned)((ln >> 4) * OPITCH + (ln & 15) * 8);
#define D2_STAGE(p) do { _Pragma("unroll") for (int rr = 0; rr < 8; ++rr) { const int r = 8 * (p) + rr, row0 = (rr & 3) + 8 * (rr >> 2);                                   \
            _Pragma("unroll") for (int d0 = 0; d0 < 4; d0 += 2) { const unsigned w = cvtpk(o[d0][r] * rli[r], o[d0 + 1][r] * rli[r]);                                        \
                *(ATT_LAS unsigned short*)(ost + wr_off + row0 * OST_ROW + d0 * 64) = (unsigned short)(w & 0xffffu);                                                        \
                *(ATT_LAS unsigned short*)(ost + wr_off + row0 * OST_ROW + (d0 + 1) * 64) = (unsigned short)(w >> 16); } }                                                  \
        asm volatile("s_waitcnt lgkmcnt(0)" ::: "memory");                                                                                                                  \
        _Pragma("unroll") for (int j = 0; j < 4; ++j) ch[j] = *(const ATT_LAS u32x4*)(ost + rd_off + (4 * j) * OST_ROW);                                                    \
        asm volatile("s_waitcnt lgkmcnt(0)" ::: "memory"); } while (0)
        if (R.m == 0) {
#pragma unroll
            for (int p = 0; p < 2; ++p) { u32x4 ch[4]; D2_STAGE(p);
#pragma unroll
                for (int j = 0; j < 4; ++j) *(u32x4*)(O1w + (size_t)(16 * p + 4 * j) * OPITCH + voff_o) = ch[j]; }
            asm volatile("s_waitcnt vmcnt(0)" ::: "memory");
        } else {
            const f32x4 gm0 = *(const f32x4*)(AB.subg + hfw * 128 + (ln & 15) * 8), gm1 = *(const f32x4*)(AB.subg + hfw * 128 + (ln & 15) * 8 + 4);
            ATT_LAS float* ssMine = (ATT_LAS float*)(ldsL + D2_SS) + (hfw * 4 + g) * 32;
            const ATT_LAS float* ssPeer = (const ATT_LAS float*)(ldsL + D2_SS) + ((1 - hfw) * 4 + g) * 32;
            float dv[2][4][8], ssr[2][4];
#pragma unroll
            for (int p = 0; p < 2; ++p) { u32x4 ch[4], q1[4];
#pragma unroll
                for (int j = 0; j < 4; ++j) q1[j] = *(const u32x4*)(O1w + (size_t)(16 * p + 4 * j) * OPITCH + voff_o);
                D2_STAGE(p);
#pragma unroll
                for (int j = 0; j < 4; ++j) { float ss = 0.f;
#pragma unroll
                    for (int e = 0; e < 4; ++e) { const unsigned a = q1[j][e], b = ch[j][e];
                        const float d0_ = __uint_as_float(a << 16) - AB.lam * __uint_as_float(b << 16), d1_ = __uint_as_float(a & 0xffff0000u) - AB.lam * __uint_as_float(b & 0xffff0000u);
                        dv[p][j][2 * e] = d0_; dv[p][j][2 * e + 1] = d1_; ss += d0_ * d0_ + d1_ * d1_; }
                    ss += __shfl_xor(ss, 1); ss += __shfl_xor(ss, 2); ss += __shfl_xor(ss, 4); ss += __shfl_xor(ss, 8);
                    ssr[p][j] = ss;
                    if ((ln & 15) == 0) ssMine[16 * p + 4 * j + (ln >> 4)] = ss; } }
            D2_BAR();
#pragma unroll
            for (int p = 0; p < 2; ++p)
#pragma unroll
                for (int j = 0; j < 4; ++j) { const float tot = ssr[p][j] + ssPeer[16 * p + 4 * j + (ln >> 4)];
                    const float rs = 0.8f / sqrtf(tot * (1.0f / 256.0f) + 1e-6f);
                    u32x4 w;
                    w.x = cvtpk(dv[p][j][0] * rs * gm0[0], dv[p][j][1] * rs * gm0[1]); w.y = cvtpk(dv[p][j][2] * rs * gm0[2], dv[p][j][3] * rs * gm0[3]);
                    w.z = cvtpk(dv[p][j][4] * rs * gm1[0], dv[p][j][5] * rs * gm1[1]); w.w = cvtpk(dv[p][j][6] * rs * gm1[2], dv[p][j][7] * rs * gm1[3]);
                    *(u32x4*)(Mw + (size_t)(16 * p + 4 * j) * OPITCH + voff_o) = w; }
        }
#undef D2_STAGE
    }
    D2_BAR();
#undef D2_BAR
#undef VMW
#undef KBASE
#undef PSLOT
#undef DMA_TILE
#undef DMA_K
#undef DMA_VA
#undef DMA_VB
#undef RESC
#undef MASKT
#undef P_PUT
#undef P_GET_PV
}
#undef BR_Q
#undef BR_K
#undef BR_V
#undef BR_O
#undef BR_CL
#undef BR_CT
#undef VMW
#undef FDMA
#undef FDMA_K
#undef FDMA_V
#undef FDMA_OFFS
constexpr int LDS_BYTES = D2_BYTES > LDS_BYTES_FOX ? D2_BYTES : LDS_BYTES_FOX;
}

constexpr int NWAVES = 8;
constexpr int BATCH = 4, SEQ = 4096, DM = 4096, M = BATCH * SEQ;
constexpr int NQKV = 12288, INCOLS = 12304, NFH = 16, DFF = 11008, NGU = 2 * DFF;
constexpr float EPS = 1e-6f;

constexpr size_t MiB = 1u << 20;
constexpr size_t WS_CTL = 0, CTL_ZERO_BYTES = 1 * MiB;
constexpr size_t WS_CUMLOC = 1 * MiB;
constexpr size_t WS_CTOT = 2 * MiB;
constexpr size_t WS_WFT = 3 * MiB;
constexpr size_t WS_WIN = 8 * MiB;
constexpr size_t WS_WO = 104 * MiB;
constexpr size_t WS_WGU = 136 * MiB;
constexpr size_t WS_WD = 308 * MiB;
constexpr size_t WS_A = 394 * MiB;
constexpr size_t WS_B = 522 * MiB;
constexpr size_t WS_XB = WS_B + 344 * MiB;
constexpr size_t WS_END = 994 * MiB;
static_assert(WS_WIN + (size_t)NQKV * DM * 2 <= WS_WO && WS_WO + (size_t)DM * DM * 2 <= WS_WGU && WS_WGU + (size_t)NGU * DM * 2 <= WS_WD && WS_WD + (size_t)DM * DFF * 2 <= WS_A
              && WS_A + (size_t)M * DM * 2 <= WS_B && WS_B + (size_t)M * NQKV * 2 <= WS_END && WS_B + (size_t)M * DFF * 2 <= WS_XB && WS_XB + (size_t)M * DM * 2 <= WS_END, "d_ws map");
constexpr int CW_TMO = 0, CW_CODE = 1;
constexpr int CW_BAR = 4096;
constexpr int CW_ROWSS = 65536;
static_assert((CW_ROWSS + 2 * M) * 4 <= (int)CTL_ZERO_BYTES, "CTL words (rowss, then rms of the input rows) inside the memset region");

constexpr int RING_OFF = 0, RING_BYTES = 131072;
constexpr int LDSCTL_OFF = 139264, MISC_OFF = LDSCTL_OFF + 320;
constexpr int LDS_BYTES = 147456;
static_assert(MISC_OFF + 128 <= LDS_BYTES && att::LDS_BYTES <= LDSCTL_OFF && RING_BYTES <= LDSCTL_OFF, "LDS map");

#define GAS __attribute__((address_space(1)))
#define LAS __attribute__((address_space(3)))
typedef unsigned short bf16;
typedef unsigned v4u __attribute__((ext_vector_type(4)));
typedef float f32x4 __attribute__((ext_vector_type(4)));
typedef short bf16x8 __attribute__((ext_vector_type(8)));
typedef GAS unsigned gu32;
#define RLX_AGENT __ATOMIC_RELAXED, __HIP_MEMORY_SCOPE_AGENT
#define LDS_WAIT() asm volatile("s_waitcnt lgkmcnt(0)" ::: "memory")
#define VM_WAIT() asm volatile("s_waitcnt vmcnt(0)" ::: "memory")
__device__ __forceinline__ unsigned f2bf(float f) { unsigned u = __builtin_bit_cast(unsigned, f); return (u + 0x7fffu + ((u >> 16) & 1u)) >> 16; }
__device__ __forceinline__ unsigned pk2(float lo, float hi) { return pg8::cvt_pk_bf16(lo, hi); }
__device__ __forceinline__ float bf2f(short s) { return __builtin_bit_cast(float, ((unsigned)(unsigned short)s) << 16); }

#define XB_TMO      128
#define XB_XCNT(j)  (256  + 64 * (j))
#define XB_XSUB(j)  (1280 + 64 * (j))
#define XB_XGEN(j)  (2304 + 64 * (j))
#define XB_TOP      3328
#define XB_TOPGEN   3392
#define XCD_BAR_WORDS 3456
#define XB_SPIN_CAP (1u << 18)

__device__ __forceinline__ unsigned xb_ld(unsigned* p)              { return __hip_atomic_load(p, __ATOMIC_RELAXED, __HIP_MEMORY_SCOPE_AGENT); }
__device__ __forceinline__ unsigned xb_add(unsigned* p, unsigned v) { return __hip_atomic_fetch_add(p, v, __ATOMIC_RELAXED, __HIP_MEMORY_SCOPE_AGENT); }
__device__ __forceinline__ unsigned xb_xcc_id() { return (unsigned)__builtin_amdgcn_s_getreg((3 << 11) | 20) & 0xFu; }
#define XB_SPIN(cond, bar) do { unsigned _sp = 0; while (cond) { __builtin_amdgcn_s_sleep(1); \
    if ((++_sp & 255u) == 0u) { if (xb_ld(&(bar)[XB_TMO])) break; if (_sp > XB_SPIN_CAP) { atomicAdd(&(bar)[XB_TMO], 1u); break; } } } } while (0)

struct XcdBarrier {
    unsigned* bar; unsigned x;
    volatile LAS unsigned* st;
};

__device__ __forceinline__ XcdBarrier xcd_barrier_post(unsigned* bar, volatile LAS unsigned* st) {
    XcdBarrier b; b.bar = bar; b.x = xb_xcc_id(); b.st = st;
    if (threadIdx.x == 0) (void)xb_add(&bar[XB_XCNT(b.x)], 1u);
    return b;
}
__device__ __forceinline__ void xcd_barrier_complete(unsigned* bar, unsigned x, unsigned& nloc, unsigned& nx) {
    const unsigned G = gridDim.x * gridDim.y * gridDim.z;
    unsigned sum, cnt, mine, sp = 0u;
    for (;;) {
        sum = 0u; cnt = 0u; mine = 0u;
#pragma unroll
        for (unsigned j = 0; j < 16; ++j) { const unsigned c = xb_ld(&bar[XB_XCNT(j)]); sum += c; cnt += (c > 0u) ? 1u : 0u; mine = (j == x) ? c : mine; }
        if (sum == G) break;
        __builtin_amdgcn_s_sleep(1);
        if ((++sp & 255u) == 0u) { if (xb_ld(&bar[XB_TMO])) break; if (sp > XB_SPIN_CAP) { atomicAdd(&bar[XB_TMO], 1u); break; } }
    }
    nloc = mine > 0u ? mine : 1u; nx = cnt > 0u ? cnt : 1u;
}

__device__ __forceinline__ void xcd_barrier(const XcdBarrier& b) {
    asm volatile("s_waitcnt vmcnt(0)" ::: "memory");
    __syncthreads();
    if (threadIdx.x == 0) {
        unsigned* bar = b.bar;
        __builtin_amdgcn_s_waitcnt(0);
        unsigned nloc = b.st[0], nx = b.st[1];
        if (nloc == 0u) { xcd_barrier_complete(bar, b.x, nloc, nx); b.st[0] = nloc; b.st[1] = nx; }
        const unsigned old = xb_add(&bar[XB_XSUB(b.x)], 1u);
        const unsigned gen = old / nloc;
        if (old + 1u == (gen + 1u) * nloc) {
            __builtin_amdgcn_fence(__ATOMIC_RELEASE, "agent");
            asm volatile("s_waitcnt vmcnt(0)" ::: "memory");
            const unsigned og = xb_add(&bar[XB_TOP], 1u);
            const unsigned tg = og / nx;
            if (og + 1u == (tg + 1u) * nx) xb_add(&bar[XB_TOPGEN], 1u);
            else XB_SPIN(xb_ld(&bar[XB_TOPGEN]) == tg, bar);
            __builtin_amdgcn_fence(__ATOMIC_ACQUIRE, "agent");
            xb_add(&bar[XB_XGEN(b.x)], 1u);
            asm volatile("s_waitcnt vmcnt(0)" ::: "memory");
        } else {
            XB_SPIN(xb_ld(&bar[XB_XGEN(b.x)]) == gen, bar);
            __builtin_amdgcn_fence(__ATOMIC_ACQUIRE, "agent");
            asm volatile("s_waitcnt vmcnt(0)" ::: "memory");
        }
    }
    __syncthreads();
}

struct Frame {
    LAS unsigned char* lds;
    volatile LAS unsigned* MISC;
    gu32* ctl;
    int tid, lane, wave;
    int vcu, G;
    const float *x, *g_attn, *w_in, *b_f, *lq1, *lk1, *lq2, *lk2, *relt, *subg, *w_o, *g_ffn, *w_gate, *w_up, *w_down, *g_final;
    float* out;
    bf16 *Win_t, *WfT, *Wo_t, *Wgu_t, *Wd_t, *bufA, *bufB, *od, *xb, *mx;
    float* rinv;
    float *cumloc, *ctot;
};
__device__ __forceinline__ float wave_sum(float v) {
    const int ln = pg8::fresh_lane();
#pragma unroll
    for (int o = 1; o < 64; o <<= 1) v += __builtin_bit_cast(float, __builtin_amdgcn_ds_bpermute((ln ^ o) << 2, __builtin_bit_cast(int, v)));
    return v;
}
template <bool GAIN> __device__ __forceinline__ void transpose_item(const float* W, int ldw, int k0, int n0, bf16* WT, int Kdst, int drow0, LAS float* scr, int lane, const float* gk = nullptr) {
#pragma unroll 8
    for (int i = 0; i < 32; ++i) { const int kk = 2 * i + (lane >> 5); scr[kk * 33 + (lane & 31)] = W[(size_t)(k0 + kk) * ldw + n0 + (lane & 31)]; }
    LDS_WAIT(); asm volatile("" ::: "memory");
    const int c = lane & 7;
    f32x4 g0 = {1.f, 1.f, 1.f, 1.f}, g1 = g0;
    if (GAIN) { g0 = *(const GAS f32x4*)(gk + k0 + 8 * c); g1 = *(const GAS f32x4*)(gk + k0 + 8 * c + 4); }
#pragma unroll
    for (int j = 0; j < 4; ++j) { const int n = (lane >> 3) + 8 * j; const LAS float* s = scr + (8 * c) * 33 + n;
        v4u o; o.x = pk2(s[0 * 33] * g0.x, s[1 * 33] * g0.y); o.y = pk2(s[2 * 33] * g0.z, s[3 * 33] * g0.w); o.z = pk2(s[4 * 33] * g1.x, s[5 * 33] * g1.y); o.w = pk2(s[6 * 33] * g1.z, s[7 * 33] * g1.w);
        *(GAS v4u*)(WT + (size_t)(drow0 + n) * Kdst + k0 + 8 * c) = o; }
    LDS_WAIT(); asm volatile("" ::: "memory");
}
template <bool OUT_BF16> __device__ __forceinline__ void norm_rows(Frame& F, const float* X, const float* g, void* out, bool bad) {
    const int tid = pg8::fresh_tid(F.wave), lane = tid & 63, wave = __builtin_amdgcn_readfirstlane(tid >> 6);
    const int gw = F.vcu * NWAVES + wave, NGW = F.G * NWAVES;
    f32x4 gv[16];
#pragma unroll
    for (int j = 0; j < 16; ++j) gv[j] = ((const GAS f32x4*)g)[lane + 64 * j];
    for (int m = gw; m < M; m += NGW) {
        const GAS f32x4* xr = (const GAS f32x4*)(X + (size_t)m * DM) + lane;
        f32x4 v[16]; float s = 0.f;
#pragma unroll
        for (int j = 0; j < 16; ++j) { v[j] = xr[64 * j]; s += (v[j].x * v[j].x + v[j].y * v[j].y) + (v[j].z * v[j].z + v[j].w * v[j].w); }
        float r = 1.0f / sqrtf(wave_sum(s) * (1.0f / DM) + EPS);
        if (bad) r = __builtin_nanf("");
        if (OUT_BF16) { GAS unsigned long long* o8 = (GAS unsigned long long*)((bf16*)out + (size_t)m * DM) + lane;
#pragma unroll
            for (int j = 0; j < 16; ++j) o8[64 * j] = (unsigned long long)pk2(v[j].x * r * gv[j].x, v[j].y * r * gv[j].y) | ((unsigned long long)pk2(v[j].z * r * gv[j].z, v[j].w * r * gv[j].w) << 32);
        } else { GAS f32x4* o = (GAS f32x4*)((float*)out + (size_t)m * DM) + lane;
#pragma unroll
            for (int j = 0; j < 16; ++j) o[64 * j] = (v[j] * r) * gv[j]; }
    }
}
__device__ __forceinline__ void rows_to_bf16(Frame& F, const float* X, bf16* out, float* rinv) {
    const int tid = pg8::fresh_tid(F.wave), lane = tid & 63, wave = __builtin_amdgcn_readfirstlane(tid >> 6);
    const int gw = F.vcu * NWAVES + wave, NGW = F.G * NWAVES;
    for (int m = gw; m < M; m += NGW) {
        const GAS f32x4* xr = (const GAS f32x4*)(X + (size_t)m * DM) + lane;
        f32x4 v[16]; float s = 0.f;
#pragma unroll
        for (int j = 0; j < 16; ++j) { v[j] = xr[64 * j]; s += (v[j].x * v[j].x + v[j].y * v[j].y) + (v[j].z * v[j].z + v[j].w * v[j].w); }
        const float r = 1.0f / sqrtf(wave_sum(s) * (1.0f / DM) + EPS);
        if (lane == 0) rinv[m] = r;
        GAS unsigned long long* o8 = (GAS unsigned long long*)(out + (size_t)m * DM) + lane;
#pragma unroll
        for (int j = 0; j < 16; ++j) o8[64 * j] = (unsigned long long)pk2(v[j].x, v[j].y) | ((unsigned long long)pk2(v[j].z, v[j].w) << 32);
    }
}
__device__ __forceinline__ void norm_rows_bf16in(Frame& F, const bf16* X, const float* g, float* out, bool bad) {
    const int tid = pg8::fresh_tid(F.wave), lane = tid & 63, wave = __builtin_amdgcn_readfirstlane(tid >> 6);
    const int gw = F.vcu * NWAVES + wave, NGW = F.G * NWAVES;
    f32x4 gv[16];
#pragma unroll
    for (int j = 0; j < 8; ++j) { gv[2 * j] = ((const GAS f32x4*)g)[2 * (lane + 64 * j)]; gv[2 * j + 1] = ((const GAS f32x4*)g)[2 * (lane + 64 * j) + 1]; }
    for (int m = gw; m < M; m += NGW) {
        const GAS v4u* xr = (const GAS v4u*)(X + (size_t)m * DM) + lane;
        f32x4 v[16]; float s = 0.f;
#pragma unroll
        for (int j = 0; j < 8; ++j) { const v4u w = xr[64 * j];
            v[2 * j] = (f32x4){__uint_as_float(w.x << 16), __uint_as_float(w.x & 0xffff0000u), __uint_as_float(w.y << 16), __uint_as_float(w.y & 0xffff0000u)};
            v[2 * j + 1] = (f32x4){__uint_as_float(w.z << 16), __uint_as_float(w.z & 0xffff0000u), __uint_as_float(w.w << 16), __uint_as_float(w.w & 0xffff0000u)}; }
#pragma unroll
        for (int j = 0; j < 16; ++j) s += (v[j].x * v[j].x + v[j].y * v[j].y) + (v[j].z * v[j].z + v[j].w * v[j].w);
        float r = 1.0f / sqrtf(wave_sum(s) * (1.0f / DM) + EPS);
        if (bad) r = __builtin_nanf("");
        GAS f32x4* o = (GAS f32x4*)(out + (size_t)m * DM) + 2 * lane;
#pragma unroll
        for (int j = 0; j < 8; ++j) { o[128 * j] = (v[2 * j] * r) * gv[2 * j]; o[128 * j + 1] = (v[2 * j + 1] * r) * gv[2 * j + 1]; }
    }
}
__device__ __forceinline__ void p0_prologue(Frame& F) {
    const int tid = pg8::fresh_tid(F.wave), lane = tid & 63, wave = __builtin_amdgcn_readfirstlane(tid >> 6);
    LAS float* scr = (LAS float*)(F.lds + RING_OFF + wave * 16384);
    const int gw = F.vcu * NWAVES + wave, NGW = F.G * NWAVES;
    constexpr int KB4 = DM / 64, KBF = DFF / 64;
    constexpr int I_IN = KB4 * (NQKV / 32), I_O = KB4 * (DM / 32), I_G = KB4 * (DFF / 32), I_D = KBF * (DM / 32);
    constexpr int NITEMS = I_IN + I_O + 2 * I_G;
    for (int it = gw; it < NITEMS; it += NGW) {
        int r = it;
        if (r < I_IN) { const int nblk = NQKV / 32, kb = r / nblk, nb = r % nblk; transpose_item<true>(F.w_in, INCOLS, 64 * kb, 32 * nb, F.Win_t, DM, 32 * nb, scr, lane, F.g_attn); continue; } r -= I_IN;
        if (r < I_O) { const int nblk = DM / 32, kb = r / nblk, nb = r % nblk; transpose_item<false>(F.w_o, DM, 64 * kb, 32 * nb, F.Wo_t, DM, 32 * nb, scr, lane); continue; } r -= I_O;
        if (r < I_G) { const int nblk = DFF / 32, kb = r / nblk, nb = r % nblk, n0 = 32 * nb; transpose_item<true>(F.w_gate, DFF, 64 * kb, n0, F.Wgu_t, DM, (n0 >> 7) * 256 + (n0 & 127), scr, lane, F.g_ffn); continue; } r -= I_G;
        { const int nblk = DFF / 32, kb = r / nblk, nb = r % nblk, n0 = 32 * nb; transpose_item<true>(F.w_up, DFF, 64 * kb, n0, F.Wgu_t, DM, (n0 >> 7) * 256 + 128 + (n0 & 127), scr, lane, F.g_ffn); }
    }
    for (int i = gw * 64 + lane; i < NFH * DM; i += NGW * 64) { const int n = i / DM, k = i % DM; F.WfT[i] = (bf16)f2bf(F.w_in[(size_t)k * INCOLS + NQKV + n] * F.g_attn[k]); }
    rows_to_bf16(F, F.x, F.bufA, F.rinv);
}
__device__ __forceinline__ void wd_convert(Frame& F, int first_wg) {
    const int tid = pg8::fresh_tid(F.wave), lane = tid & 63, wave = __builtin_amdgcn_readfirstlane(tid >> 6);
    LAS float* scr = (LAS float*)(F.lds + RING_OFF + wave * 16384);
    const int nw = (F.G - first_wg) * NWAVES, w0 = ((int)blockIdx.x - first_wg) * NWAVES + wave;
    constexpr int I_D = (DFF / 64) * (DM / 32);
    for (int r = w0; r < I_D; r += nw) { const int nblk = DM / 32, kb = r / nblk, nb = r % nblk; transpose_item<false>(F.w_down, DM, 64 * kb, 32 * nb, F.Wd_t, DFF, 32 * nb, scr, lane); }
}
__device__ __forceinline__ void flogit_phase(Frame& F) {
    LAS float* part = (LAS float*)(F.lds + RING_OFF);
    LAS float* ls = (LAS float*)(F.lds + RING_OFF + 4096);
    const int tid = pg8::fresh_tid(F.wave), lane = tid & 63, wave = __builtin_amdgcn_readfirstlane(tid >> 6);
    const int g = wave & 3, kh = wave >> 2, n = lane & 15, q = lane >> 4;
    for (int c = blockIdx.x; c < M / 64; c += F.G) {
        const int r0 = 64 * c;
        const bf16* hrow = F.bufA + (size_t)(r0 + 16 * g + n) * DM + kh * 2048 + 8 * q;
        const bf16* wrow = F.WfT + (size_t)n * DM + kh * 2048 + 8 * q;
        f32x4 acc = {0.f, 0.f, 0.f, 0.f};
#pragma unroll 8
        for (int s = 0; s < 64; ++s) { const bf16x8 a = *(const GAS bf16x8*)(hrow + 32 * s); const bf16x8 b = *(const GAS bf16x8*)(wrow + 32 * s);
            acc = __builtin_amdgcn_mfma_f32_16x16x32_bf16(a, b, acc, 0, 0, 0); }
        if (kh == 1) {
#pragma unroll
            for (int e = 0; e < 4; ++e) part[(16 * g + 4 * q + e) * 16 + n] = acc[e]; }
        __syncthreads();
        if (kh == 0) { const float bf = F.b_f[n];
#pragma unroll
            for (int e = 0; e < 4; ++e) { const float v = (acc[e] + part[(16 * g + 4 * q + e) * 16 + n]) * F.rinv[r0 + 16 * g + 4 * q + e] + bf;
                ls[(16 * g + 4 * q + e) * 16 + n] = fminf(v, 0.f) - log1pf(expf(-fabsf(v))); } }
        __syncthreads();
        if (wave == 0) {
            float v[16]; float run = 0.f;
#pragma unroll
            for (int j = 0; j < 16; ++j) { run += ls[(16 * q + j) * 16 + n]; v[j] = run; }
            const float t0 = __shfl(run, n), t1 = __shfl(run, n + 16), t2 = __shfl(run, n + 32);
            const float off = (q > 0 ? t0 : 0.f) + (q > 1 ? t1 : 0.f) + (q > 2 ? t2 : 0.f);
            const int b = r0 / SEQ, s0 = r0 % SEQ;
            float* dst = F.cumloc + (size_t)(b * NFH + n) * SEQ + s0 + 16 * q;
#pragma unroll
            for (int j = 0; j < 16; j += 4) *(GAS f32x4*)(dst + j) = (f32x4){v[j] + off, v[j + 1] + off, v[j + 2] + off, v[j + 3] + off};
            if (q == 3) F.ctot[(b * NFH + n) * 64 + (s0 >> 6)] = run + off;
        }
        __syncthreads();
    }
}
constexpr int D2_ITEMS = 32 * 16;
__device__ __forceinline__ att::Ref2 diff_ref(int L, int blk) {
    const int rr = L >> 8, w = L & 255, sigma = rr * 16 + (w & 7) * 2 + (w >> 7), pair = (w >> 3) & 15;
    const int qb = (blk >> 1) ? 31 - pair : pair, m = blk & 1;
    const int b = sigma >> 3, h = sigma & 7;
    att::Ref2 r; r.b = b; r.P0 = qb * 128; r.qcol = h * 2 + m; r.kcol = 16 + h * 2 + m; r.vcol = 32 + h * 2; r.head = h; r.m = m;
    return r;
}
constexpr int FOX_ITEMS = 64 * 8;
__device__ __forceinline__ att::BlockRef fox_ref(int L, int pass) {
    const int rr = L >> 8, w = L & 255, sigma = rr * 32 + (w & 7) * 4 + (w >> 6), pair = (w >> 3) & 7;
    const int qb = pass ? 15 - pair : pair;
    const int b = sigma >> 4, h = sigma & 15;
    att::BlockRef r; r.b = b; r.P0 = qb * 256; r.qcol = 48 + h; r.kcol = 64 + h; r.vcol = 80 + h; r.ocol = 2048 + h * 128; r.kind = 1; r.head = h;
    return r;
}
template <int ROLE> __device__ __forceinline__ void fox_run(Frame& F, char* lds) {
    int L = blockIdx.x;
    const int tid = pg8::fresh_tid(F.wave);
    const att::AttnBases AB{__builtin_amdgcn_make_buffer_rsrc((void*)F.bufB, 0, (int)((size_t)M * NQKV * 2), 0x00020000), F.od, F.mx, F.cumloc, F.ctot, F.relt, F.subg, 0.f};
    const int stride = F.G;
    int pass = 0;
    att::BlockRef cur = fox_ref(L, 0);
    att::Seam S;
    att::attn_prime(AB, cur, F.lds + RING_OFF, S, tid);
    for (;;) {
        const bool more_pass = pass == 0, more_item = L + stride < FOX_ITEMS, last = !more_pass && !more_item;
        int passn = pass + 1, Ln = L;
        if (!more_pass) { passn = 0; Ln = more_item ? L + stride : L; }
        const att::BlockRef nxt = last ? cur : fox_ref(Ln, passn);
        if (pass == 0) att::attn_tables(AB, fox_ref(L, 1), F.lds + RING_OFF, tid);
        att::attn_block<1, ROLE>(AB, cur, nxt, lds, F.lds + RING_OFF, S, tid);
        if (last) break;
        cur = nxt; pass = passn; L = Ln;
    }
}
__device__ __forceinline__ void fox_phase(Frame& F, char* lds) {
    if ((int)blockIdx.x >= FOX_ITEMS) return;
    if (F.wave < 4) fox_run<0>(F, lds); else fox_run<1>(F, lds);
}
__device__ __forceinline__ void diff_phase(Frame& F, char* lds) {
    const int tid = pg8::fresh_tid(F.wave);
    float lam;
    {   const int l = tid & 63;
        const float s1 = wave_sum(F.lq1[l] * F.lk1[l] + F.lq1[l + 64] * F.lk1[l + 64]), s2 = wave_sum(F.lq2[l] * F.lk2[l] + F.lq2[l + 64] * F.lk2[l + 64]);
        lam = __builtin_bit_cast(float, __builtin_amdgcn_readfirstlane(__builtin_bit_cast(int, expf(s1) - expf(s2) + 0.2f))); }
    const att::AttnBases AB{__builtin_amdgcn_make_buffer_rsrc((void*)F.bufB, 0, (int)((size_t)M * NQKV * 2), 0x00020000), F.od, F.mx, F.cumloc, F.ctot, F.relt, F.subg, lam};
    for (int L = blockIdx.x; L < D2_ITEMS; L += F.G) {
#pragma unroll 1
        for (int blk = 0; blk < 4; ++blk) att::diff_block(AB, diff_ref(L, blk), lds, F.lds + RING_OFF, tid);
    }
}
struct Args { const float* in[16]; float* out; unsigned char* ws; };
__global__ void __launch_bounds__(NWAVES * 64, 2) hybrid_fwd(Args args) {
    extern __shared__ __attribute__((aligned(16))) unsigned char lds[];
    Frame F;
    F.lds = (LAS unsigned char*)lds;
    F.MISC = (volatile LAS unsigned*)(F.lds + MISC_OFF);
    F.tid = threadIdx.x; F.lane = F.tid & 63; F.wave = __builtin_amdgcn_readfirstlane(F.tid >> 6);
    F.G = gridDim.x; { const int bx = blockIdx.x; F.vcu = (F.G % 8 == 0) ? (bx % 8) * (F.G / 8) + bx / 8 : bx; }
    unsigned char* ws = args.ws;
    F.ctl = (gu32*)(ws + WS_CTL);
    F.x = args.in[0]; F.g_attn = args.in[1]; F.w_in = args.in[2]; F.b_f = args.in[3]; F.lq1 = args.in[4]; F.lk1 = args.in[5]; F.lq2 = args.in[6]; F.lk2 = args.in[7];
    F.relt = args.in[8]; F.subg = args.in[9]; F.w_o = args.in[10]; F.g_ffn = args.in[11]; F.w_gate = args.in[12]; F.w_up = args.in[13]; F.w_down = args.in[14]; F.g_final = args.in[15];
    F.out = args.out;
    F.Win_t = (bf16*)(ws + WS_WIN); F.WfT = (bf16*)(ws + WS_WFT); F.Wo_t = (bf16*)(ws + WS_WO); F.Wgu_t = (bf16*)(ws + WS_WGU); F.Wd_t = (bf16*)(ws + WS_WD);
    F.bufA = (bf16*)(ws + WS_A); F.bufB = (bf16*)(ws + WS_B); F.od = (bf16*)args.out; F.xb = (bf16*)(ws + WS_XB);
    F.cumloc = (float*)(ws + WS_CUMLOC); F.ctot = (float*)(ws + WS_CTOT);
    F.mx = F.od + (size_t)M * DM; F.rinv = (float*)(F.ctl + CW_ROWSS + M);
    for (int u = F.tid; u < (LDS_BYTES - LDSCTL_OFF) / 4; u += NWAVES * 64) ((LAS unsigned*)(F.lds + LDSCTL_OFF))[u] = 0u;
    __syncthreads();
    XcdBarrier bar = xcd_barrier_post((unsigned*)(F.ctl + CW_BAR), F.MISC + 8);
#define GRID_BAR() xcd_barrier(bar)

    p0_prologue(F);
    GRID_BAR();
    flogit_phase(F);
    {   pg8::Gemm g{F.bufA, F.Win_t, M, NQKV, DM}; pg8::StaticOrder S; S.init(M, NQKV, F.G, (int)blockIdx.x);
        pg8::EpiQKVSlab E{F.bufB, SEQ, F.rinv};
        pg8::gemm_phase<pg8::EpiQKVSlab, pg8::StaticOrder, true, true>(F.lds + RING_OFF, g, S, E, F.wave); }
    GRID_BAR();
    fox_phase(F, (char*)lds + RING_OFF);
    __syncthreads();
    diff_phase(F, (char*)lds + RING_OFF);
    GRID_BAR();
    {   pg8::Gemm g{F.mx, F.Wo_t, M, DM, DM}; pg8::StaticOrder S; S.init(M, DM, F.G, (int)blockIdx.x);
        pg8::EpiResBToBf16Stats E{F.bufA, F.xb, DM, (float*)(F.ctl + CW_ROWSS)};
        pg8::gemm_phase<pg8::EpiResBToBf16Stats, pg8::StaticOrder, true, true>(F.lds + RING_OFF, g, S, E, F.wave); }
    GRID_BAR();
    {   pg8::Gemm g{F.xb, F.Wgu_t, M, NGU, DM}; pg8::StaticOrder S; S.init(M, NGU, F.G, (int)blockIdx.x);
        pg8::EpiSwiGLU E{F.bufB, DFF, (const float*)(F.ctl + CW_ROWSS), 1.0f / DM, EPS};
        pg8::gemm_phase<pg8::EpiSwiGLU, pg8::StaticOrder, true, true>(F.lds + RING_OFF, g, S, E, F.wave);
        const int rem = ((M / 256) * (NGU / 256)) % F.G;
        if ((int)blockIdx.x >= rem) wd_convert(F, rem); }
    GRID_BAR();
    {   pg8::Gemm g{F.bufB, F.Wd_t, M, DM, DFF}; pg8::StaticOrder S; S.init(M, DM, F.G, (int)blockIdx.x);
        pg8::EpiResBf16 E{F.xb, F.bufA, DM};
        pg8::gemm_phase<pg8::EpiResBf16, pg8::StaticOrder, true, true>(F.lds + RING_OFF, g, S, E, F.wave); }
    GRID_BAR();
    {   const bool bad = __hip_atomic_load(F.ctl + CW_BAR + XB_TMO, RLX_AGENT) != 0u || __hip_atomic_load(F.ctl + CW_TMO, RLX_AGENT) != 0u;
        norm_rows_bf16in(F, F.bufA, F.g_final, F.out, bad); }
#undef GRID_BAR
}

extern "C" void kernel_launch(void* const* d_in, const int* in_sizes, int n_in, void* d_out, int out_size, void* d_ws, size_t ws_size, hipStream_t stream) {
    static int grid = 0;
    if (grid == 0) {
        if (n_in != 16 || in_sizes[0] != M * DM || out_size != M * DM || ws_size < WS_END) { fprintf(stderr, "kernel_launch: shape/workspace mismatch (n_in %d, in0 %d, out %d, ws %zu); nothing launched\n", n_in, n_in > 0 ? in_sizes[0] : -1, out_size, ws_size); grid = -1; return; }
        int dev = 0, cus = 0, per_cu = 0;
        if (hipGetDevice(&dev) != hipSuccess || hipDeviceGetAttribute(&cus, hipDeviceAttributeMultiprocessorCount, dev) != hipSuccess) { fprintf(stderr, "kernel_launch: device query failed\n"); grid = -1; return; }
        if (hipFuncSetAttribute((const void*)hybrid_fwd, hipFuncAttributeMaxDynamicSharedMemorySize, LDS_BYTES) != hipSuccess) { fprintf(stderr, "kernel_launch: hipFuncSetAttribute failed\n"); grid = -1; return; }
        if (hipOccupancyMaxActiveBlocksPerMultiprocessor(&per_cu, (const void*)hybrid_fwd, NWAVES * 64, LDS_BYTES) != hipSuccess || per_cu < 1)
            fprintf(stderr, "kernel_launch: note: occupancy query reports %d workgroups per CU\n", per_cu);
        (void)hipGetLastError();
        grid = cus;
    }
    if (grid < 0) return;
    if (hipMemsetAsync((char*)d_ws + WS_CTL, 0, CTL_ZERO_BYTES, stream) != hipSuccess) { fprintf(stderr, "kernel_launch: hipMemsetAsync failed\n"); return; }
    Args a{};
    for (int i = 0; i < 16; ++i) a.in[i] = (const float*)d_in[i];
    a.out = (float*)d_out; a.ws = (unsigned char*)d_ws;
    hipLaunchKernelGGL(hybrid_fwd, dim3(grid), dim3(NWAVES * 64), LDS_BYTES, stream, a);
    const hipError_t le = hipPeekAtLastError();
    if (le != hipSuccess) fprintf(stderr, "kernel_launch: launch failed: %s\n", hipGetErrorName(le));
}
```
